# Optimizing an MI355X kernel written in HIP

```python
import math
import jax, jax.numpy as jnp
from jax import lax
import numpy as np

D_MODEL = 1024
BATCH = 8
SEQ = 8192
DEPTH = 1

GRID_W = 64
WIN_H = 8
WIN_W = 16
HEAD_DIM = 64
ATTN_WIDTH = D_MODEL // 2
ATTN_HEADS = ATTN_WIDTH // HEAD_DIM
S5_WIDTH = D_MODEL - ATTN_WIDTH
S5_GROUP_CH = 16
S5_GROUPS = S5_WIDTH // S5_GROUP_CH
S5_STATE = 64
DT_MIN = 1e-3
DT_MAX = 1e-1
MIX_WIDTH = ATTN_WIDTH + S5_WIDTH
IN_WIDTH = 3 * ATTN_WIDTH + S5_WIDTH
N_EXPERT_GROUPS = 8
EXPERTS_PER_GROUP = 8
N_EXPERTS = N_EXPERT_GROUPS * EXPERTS_PER_GROUP
TOP_K_IN_GROUP = 2
D_EXPERT = D_MODEL // 2
MOE_BLOCK = 128
LN_EPS = 1e-5

kernel_name = "hybrid_natten_s5_hiermoe_deepnorm"


def layer_norm(x, g, b):
    x32 = x.astype(jnp.float32)
    mu = jnp.mean(x32, axis=-1, keepdims=True)
    var = jnp.mean(jnp.square(x32 - mu), axis=-1, keepdims=True)
    y = (x32 - mu) * lax.rsqrt(var + LN_EPS) * g.astype(jnp.float32) + b.astype(jnp.float32)
    return y.astype(x.dtype)


def neighbourhood_attention(q, k, v, rpb):
    bsz, seq, heads, dh = q.shape
    rows = seq // GRID_W
    kh = min(WIN_H, rows)
    qg = q.reshape(bsz, rows, GRID_W, heads, dh) * (dh ** -0.5)
    kg = k.reshape(bsz, rows, GRID_W, heads, dh)
    vg = v.reshape(bsz, rows, GRID_W, heads, dh)
    col = np.arange(GRID_W)
    cstart = np.clip(col - WIN_W // 2, 0, GRID_W - WIN_W)
    cidx = cstart[:, None] + np.arange(WIN_W)[None, :]
    dcol = cidx - col[:, None] + (WIN_W - 1)
    rpb_c = rpb.astype(jnp.float32)[:, :, dcol]

    def one_row(r):
        rs = jnp.clip(r - kh // 2, 0, rows - kh)
        q_r = lax.dynamic_index_in_dim(qg, r, axis=1, keepdims=False)
        k_band = lax.dynamic_slice_in_dim(kg, rs, kh, axis=1)
        v_band = lax.dynamic_slice_in_dim(vg, rs, kh, axis=1)
        k_win = k_band[:, :, cidx]
        v_win = v_band[:, :, cidx]
        s = jnp.einsum('bchd,bicjhd->bhcij', q_r, k_win).astype(jnp.float32)
        drow = rs + jnp.arange(kh) - r + (WIN_H - 1)
        bias = jnp.take(rpb_c, drow, axis=1)
        s = s + jnp.transpose(bias, (0, 2, 1, 3))[None]
        p = jax.nn.softmax(s.reshape(bsz, heads, GRID_W, kh * WIN_W), axis=-1)
        p = p.reshape(bsz, heads, GRID_W, kh, WIN_W).astype(v.dtype)
        return jnp.einsum('bhcij,bicjhd->bchd', p, v_win)

    out = lax.map(one_row, jnp.arange(rows))
    return jnp.transpose(out, (1, 0, 2, 3, 4)).reshape(bsz, seq, heads * dh)


def _ssm_combine(e1, e2):
    a1r, a1i, b1r, b1i = e1
    a2r, a2i, b2r, b2i = e2
    ar = a2r * a1r - a2i * a1i
    ai = a2r * a1i + a2i * a1r
    br = a2r * b1r - a2i * b1i + b2r
    bi = a2r * b1i + a2i * b1r + b2i
    return (ar, ai, br, bi)


def s5_bidirectional(u, a_re, a_im, log_dt, b_re, b_im, c_re, c_im, d_skip):
    f32 = jnp.float32
    u32 = u.astype(f32)
    seq = u.shape[1]
    y = d_skip.astype(f32)[None, None] * u32
    for direction in range(2):
        ar = a_re[direction].astype(f32)
        ai = a_im[direction].astype(f32)
        dt = jnp.exp(log_dt[direction].astype(f32))[:, None]
        mag = jnp.exp(ar * dt)
        lr = mag * jnp.cos(ai * dt)
        li = mag * jnp.sin(ai * dt)
        den = ar * ar + ai * ai
        zr = ((lr - 1.0) * ar + li * ai) / den
        zi = (li * ar - (lr - 1.0) * ai) / den
        br = b_re[direction].astype(f32)
        bi = b_im[direction].astype(f32)
        bbr = zr[..., None] * br - zi[..., None] * bi
        bbi = zr[..., None] * bi + zi[..., None] * br
        xr = jnp.einsum('bsgc,gpc->bsgp', u32, bbr)
        xi = jnp.einsum('bsgc,gpc->bsgp', u32, bbi)
        shp = (1, seq) + lr.shape
        lam_r = jnp.broadcast_to(lr[None, None], shp)
        lam_i = jnp.broadcast_to(li[None, None], shp)
        _, _, hr, hi = lax.associative_scan(
            _ssm_combine, (lam_r, lam_i, xr, xi), reverse=(direction == 1), axis=1)
        y = y + jnp.einsum('bsgp,gcp->bsgc', hr, c_re[direction].astype(f32)) \
              - jnp.einsum('bsgp,gcp->bsgc', hi, c_im[direction].astype(f32))
    return y


def hybrid_mixer(h, w_in, rpb, s5_a_re, s5_a_im, s5_log_dt, s5_b_re, s5_b_im,
                 s5_c_re, s5_c_im, s5_d, w_glu, b_glu, w_out):
    bsz, seq, _ = h.shape
    proj = h @ w_in
    q = proj[..., :ATTN_WIDTH].reshape(bsz, seq, ATTN_HEADS, HEAD_DIM)
    k = proj[..., ATTN_WIDTH:2 * ATTN_WIDTH].reshape(bsz, seq, ATTN_HEADS, HEAD_DIM)
    v = proj[..., 2 * ATTN_WIDTH:3 * ATTN_WIDTH].reshape(bsz, seq, ATTN_HEADS, HEAD_DIM)
    u = proj[..., 3 * ATTN_WIDTH:].reshape(bsz, seq, S5_GROUPS, S5_GROUP_CH)
    attn = neighbourhood_attention(q, k, v, rpb)
    ssm = s5_bidirectional(u, s5_a_re, s5_a_im, s5_log_dt, s5_b_re, s5_b_im,
                           s5_c_re, s5_c_im, s5_d).reshape(bsz, seq, S5_WIDTH)
    ssm = jax.nn.gelu(ssm).astype(h.dtype)
    ssm = ssm * jax.nn.sigmoid(ssm @ w_glu + b_glu)
    return jnp.concatenate([attn, ssm], axis=-1) @ w_out


def hierarchical_moe(h, w_rg, b_rg, w_re, b_re, w_gate, w_up, w_down):
    bsz, seq, dm = h.shape
    n_tok = bsz * seq
    t = h.reshape(n_tok, dm)
    g_prob = jax.nn.softmax((t @ w_rg).astype(jnp.float32) + b_rg.astype(jnp.float32), axis=-1)
    g_val, g_idx = lax.top_k(g_prob, 1)
    e_logits = ((t @ w_re).astype(jnp.float32) + b_re.astype(jnp.float32))
    e_logits = e_logits.reshape(n_tok, N_EXPERT_GROUPS, EXPERTS_PER_GROUP)
    e_in = jnp.take_along_axis(e_logits, g_idx[:, :, None], axis=1)[:, 0]
    e_top, e_loc = lax.top_k(e_in, TOP_K_IN_GROUP)
    gate = g_val * jax.nn.softmax(e_top, axis=-1)
    expert = g_idx * EXPERTS_PER_GROUP + e_loc

    n_assign = n_tok * TOP_K_IN_GROUP
    flat_e = expert.reshape(-1).astype(jnp.int32)
    flat_tok = jnp.repeat(jnp.arange(n_tok, dtype=jnp.int32), TOP_K_IN_GROUP)
    flat_w = gate.reshape(-1)
    order = jnp.argsort(flat_e)
    se, stok, sw = flat_e[order], flat_tok[order], flat_w[order]
    counts = jnp.bincount(flat_e, length=N_EXPERTS)
    starts = jnp.cumsum(counts) - counts
    padded = (counts + MOE_BLOCK - 1) // MOE_BLOCK * MOE_BLOCK
    pends = jnp.cumsum(padded)
    pstarts = pends - padded
    dest = pstarts[se] + (jnp.arange(n_assign, dtype=jnp.int32) - starts[se])
    n_blocks = (n_assign + N_EXPERTS * (MOE_BLOCK - 1) + MOE_BLOCK - 1) // MOE_BLOCK
    buf = jnp.zeros((n_blocks * MOE_BLOCK, dm), t.dtype).at[dest].set(t[stok])
    block_expert = jnp.minimum(
        jnp.searchsorted(pends, jnp.arange(n_blocks) * MOE_BLOCK, side='right'), N_EXPERTS - 1)

    def expert_block(args):
        xb, e = args
        hid = jax.nn.silu(xb @ w_gate[e]) * (xb @ w_up[e])
        return hid @ w_down[e]

    out = lax.map(expert_block, (buf.reshape(n_blocks, MOE_BLOCK, dm), block_expert))
    out = out.reshape(n_blocks * MOE_BLOCK, dm)
    contrib = out[dest].astype(jnp.float32) * sw[:, None]
    y = jnp.zeros((n_tok, dm), jnp.float32).at[stok].add(contrib)
    return y.astype(h.dtype).reshape(bsz, seq, dm)


def setup_inputs(seed: int = 0) -> dict:
    key = jax.random.key(seed)
    ks = jax.random.split(key, 24)
    beta = (8.0 * DEPTH) ** -0.25
    L, G, P, C = DEPTH, S5_GROUPS, S5_STATE, S5_GROUP_CH
    nrm = lambda k, shape: jax.random.normal(k, shape, jnp.float32)
    x = nrm(ks[0], (BATCH, SEQ, D_MODEL))
    w_in = nrm(ks[1], (L, D_MODEL, IN_WIDTH)) * D_MODEL ** -0.5
    w_in = w_in.at[:, :, 2 * ATTN_WIDTH:3 * ATTN_WIDTH].multiply(beta)
    rpb = 0.02 * nrm(ks[2], (L, ATTN_HEADS, 2 * WIN_H - 1, 2 * WIN_W - 1))
    s5_a_re = -0.5 + 0.01 * nrm(ks[3], (L, 2, G, P))
    s5_a_im = math.pi * jnp.arange(P, dtype=jnp.float32) + 0.01 * nrm(ks[4], (L, 2, G, P))
    s5_log_dt = math.log(DT_MIN) + jax.random.uniform(ks[5], (L, 2, G), jnp.float32) * (
        math.log(DT_MAX) - math.log(DT_MIN))
    s5_b_re = nrm(ks[6], (L, 2, G, P, C)) * (2.0 * C) ** -0.5
    s5_b_im = nrm(ks[7], (L, 2, G, P, C)) * (2.0 * C) ** -0.5
    s5_c_re = nrm(ks[8], (L, 2, G, C, P)) * P ** -0.5
    s5_c_im = nrm(ks[9], (L, 2, G, C, P)) * P ** -0.5
    s5_d = nrm(ks[10], (L, G, C))
    w_glu = nrm(ks[11], (L, S5_WIDTH, S5_WIDTH)) * S5_WIDTH ** -0.5
    b_glu = 0.01 * nrm(ks[12], (L, S5_WIDTH))
    w_out = nrm(ks[13], (L, MIX_WIDTH, D_MODEL)) * MIX_WIDTH ** -0.5 * beta
    ln1_g = 1.0 + 0.01 * nrm(ks[14], (L, D_MODEL))
    ln1_b = 0.01 * nrm(ks[15], (L, D_MODEL))
    w_router_group = nrm(ks[16], (L, D_MODEL, N_EXPERT_GROUPS)) * D_MODEL ** -0.5
    b_router_group = 0.01 * nrm(ks[17], (L, N_EXPERT_GROUPS))
    w_router_expert = nrm(ks[18], (L, D_MODEL, N_EXPERTS)) * D_MODEL ** -0.5
    b_router_expert = 0.01 * nrm(ks[19], (L, N_EXPERTS))
    w_gate = nrm(ks[20], (L, N_EXPERTS, D_MODEL, D_EXPERT)) * D_MODEL ** -0.5
    w_up = nrm(ks[21], (L, N_EXPERTS, D_MODEL, D_EXPERT)) * D_MODEL ** -0.5
    w_down = nrm(ks[22], (L, N_EXPERTS, D_EXPERT, D_MODEL)) * D_EXPERT ** -0.5 * beta
    ks2 = jax.random.split(ks[23], 2)
    ln2_g = 1.0 + 0.01 * nrm(ks2[0], (L, D_MODEL))
    ln2_b = 0.01 * nrm(ks2[1], (L, D_MODEL))
    return {"x": x, "w_in": w_in, "rpb": rpb, "s5_a_re": s5_a_re, "s5_a_im": s5_a_im,
            "s5_log_dt": s5_log_dt, "s5_b_re": s5_b_re, "s5_b_im": s5_b_im,
            "s5_c_re": s5_c_re, "s5_c_im": s5_c_im, "s5_d": s5_d, "w_glu": w_glu,
            "b_glu": b_glu, "w_out": w_out, "ln1_g": ln1_g, "ln1_b": ln1_b,
            "w_router_group": w_router_group, "b_router_group": b_router_group,
            "w_router_expert": w_router_expert, "b_router_expert": b_router_expert,
            "w_gate": w_gate, "w_up": w_up, "w_down": w_down,
            "ln2_g": ln2_g, "ln2_b": ln2_b}


def reference(x, w_in, rpb, s5_a_re, s5_a_im, s5_log_dt, s5_b_re, s5_b_im, s5_c_re,
              s5_c_im, s5_d, w_glu, b_glu, w_out, ln1_g, ln1_b, w_router_group,
              b_router_group, w_router_expert, b_router_expert, w_gate, w_up, w_down,
              ln2_g, ln2_b):
    alpha = (2.0 * DEPTH) ** 0.25
    h = x
    for layer in range(DEPTH):
        mix = hybrid_mixer(h, w_in[layer], rpb[layer], s5_a_re[layer], s5_a_im[layer],
                           s5_log_dt[layer], s5_b_re[layer], s5_b_im[layer], s5_c_re[layer],
                           s5_c_im[layer], s5_d[layer], w_glu[layer], b_glu[layer], w_out[layer])
        h = layer_norm(alpha * h + mix, ln1_g[layer], ln1_b[layer])
        ffn = hierarchical_moe(h, w_router_group[layer], b_router_group[layer],
                               w_router_expert[layer], b_router_expert[layer],
                               w_gate[layer], w_up[layer], w_down[layer])
        h = layer_norm(alpha * h + ffn, ln2_g[layer], ln2_b[layer])
    return h
```

```cpp
#include <hip/hip_runtime.h>
#include <cstdio>
#include <cstdint>

#define GAS __attribute__((address_space(1)))
#define LAS __attribute__((address_space(3)))
typedef unsigned short bf16;
typedef float f32x4 __attribute__((ext_vector_type(4)));
typedef unsigned u32x4 __attribute__((ext_vector_type(4)));
typedef unsigned u32x2 __attribute__((ext_vector_type(2)));
typedef short s16x4 __attribute__((ext_vector_type(4)));
typedef int v8i __attribute__((ext_vector_type(8)));
typedef float f32x2_t __attribute__((ext_vector_type(2)));
typedef unsigned char fp8;

constexpr int D = 1024, NBATCH = 8, SEQ = 8192, T = NBATCH * SEQ, GW = 64, ROWS = SEQ / GW, NH = 8, HD = 64, AW = 512, SW = 512;
constexpr int SG = 32, SC = 16, SP = 64, INW = 2048, NEG = 8, EPG = 8, NE = 64, DE = 512;
constexpr int TB = 32;
constexpr int NBLK = T / TB;
constexpr int UAW = TB * SC + 4 * SP;
constexpr float LN_EPS = 1e-5f;
constexpr float ALPHA = 1.189207115002721f;
constexpr int MAXTILES = (2 * T + NE * 255) / 256 + 1;
constexpr int NWAVES = 8, NTHR = 512;
constexpr int ECAP = 2 * T;

constexpr size_t MiB = 1u << 20;
constexpr size_t WS_CTL = 0, CTL_ZERO_BYTES = 1 * MiB;
constexpr size_t WS_TOKE = 1 * MiB, WS_TOKPOS = WS_TOKE + 512 * 1024, WS_TOKW = 2 * MiB;
constexpr size_t WS_S5TAB = 5 * MiB;
constexpr size_t WS_WIN_T = 8 * MiB, WS_WGLU_T = 12 * MiB, WS_WR_T = 12 * MiB + 512 * 1024, WS_WOUT_T = 13 * MiB;
constexpr size_t WS_KY = 16 * MiB, WS_WE = 40 * MiB, WS_WGU_T = 48 * MiB, WS_WDN_T = 176 * MiB;
constexpr size_t WS_XB = 240 * MiB, WS_Z1 = 240 * MiB;
constexpr size_t WS_Q = 368 * MiB, WS_K = 432 * MiB, WS_V = 496 * MiB, WS_UA = 560 * MiB, WS_E = 656 * MiB, WS_G = 720 * MiB, WS_MIX = 784 * MiB, WS_H1 = 784 * MiB;
constexpr size_t WS_HID = 784 * MiB  , WS_O = 384 * MiB, WS_H1F = 912 * MiB  , WS_ELIST = 976 * MiB  , WS_STATS = 1008 * MiB  , WS_MR = 1016 * MiB  , WS_END = 1017 * MiB;
constexpr int CW_TMO = 0, CW_XQ = 512  , CW_MQ = 576  , CW_CNT = 1024  , CW_BAR = 4096;

constexpr int LDS_BYTES = 163840;

__device__ __forceinline__ float bf2f(bf16 b) { return __uint_as_float(((unsigned)b) << 16); }
__device__ __forceinline__ bf16 f2bf(float f) { unsigned u = __float_as_uint(f); return (bf16)((u + 0x7fffu + ((u >> 16) & 1u)) >> 16); }
__device__ __forceinline__ unsigned pk2(float lo, float hi) { return (unsigned)f2bf(lo) | ((unsigned)f2bf(hi) << 16); }
__device__ __forceinline__ unsigned pk4_fp8(float a, float b, float c, float d) { int w = 0; w = __builtin_amdgcn_cvt_pk_fp8_f32(a, b, w, false); w = __builtin_amdgcn_cvt_pk_fp8_f32(c, d, w, true); return (unsigned)w; }
__device__ __forceinline__ float xadd16(float x) { const unsigned b = __float_as_uint(x); const auto r = __builtin_amdgcn_permlane16_swap(b, b, false, false); return __uint_as_float(r[0]) + __uint_as_float(r[1]); }
__device__ __forceinline__ float xadd32(float x) { const unsigned b = __float_as_uint(x); const auto r = __builtin_amdgcn_permlane32_swap(b, b, false, false); return __uint_as_float(r[0]) + __uint_as_float(r[1]); }
__device__ __forceinline__ float xmax16(float x) { const unsigned b = __float_as_uint(x); const auto r = __builtin_amdgcn_permlane16_swap(b, b, false, false); return fmaxf(__uint_as_float(r[0]), __uint_as_float(r[1])); }
__device__ __forceinline__ float xmax32(float x) { const unsigned b = __float_as_uint(x); const auto r = __builtin_amdgcn_permlane32_swap(b, b, false, false); return fmaxf(__uint_as_float(r[0]), __uint_as_float(r[1])); }
__device__ __forceinline__ float wave_sum(float v) {
#pragma unroll
    for (int o = 1; o < 64; o <<= 1) v += __shfl_xor(v, o);
    return v;
}
__device__ __forceinline__ float sigmoidf_(float x) { return __builtin_amdgcn_rcpf(1.0f + __builtin_amdgcn_exp2f(-1.4426950408889634f * x)); }
__device__ __forceinline__ float gelu_tanh(float x) { const float z = 0.7978845608028654f * (x + 0.044715f * x * x * x); return x * sigmoidf_(2.0f * z); }

#define XB_TMO      128
#define XB_XCNT(j)  (256  + 64 * (j))
#define XB_XSUB(j)  (1280 + 64 * (j))
#define XB_XGEN(j)  (2304 + 64 * (j))
#define XB_TOP      3328
#define XB_TOPGEN   3392
#define XCD_BAR_WORDS 3456
#define XB_SPIN_CAP (1u << 18)
__device__ __forceinline__ unsigned xb_ld(unsigned* p)              { return __hip_atomic_load(p, __ATOMIC_RELAXED, __HIP_MEMORY_SCOPE_AGENT); }
__device__ __forceinline__ unsigned xb_add(unsigned* p, unsigned v) { return __hip_atomic_fetch_add(p, v, __ATOMIC_RELAXED, __HIP_MEMORY_SCOPE_AGENT); }
__device__ __forceinline__ unsigned xb_xcc_id() { return (unsigned)__builtin_amdgcn_s_getreg((3 << 11) | 20) & 0xFu; }
#define XB_SPIN(cond, bar) do { unsigned _sp = 0; while (cond) { __builtin_amdgcn_s_sleep(1); \
    if ((++_sp & 255u) == 0u) { if (xb_ld(&(bar)[XB_TMO])) break; if (_sp > XB_SPIN_CAP) { atomicAdd(&(bar)[XB_TMO], 1u); break; } } } } while (0)
struct XcdBarrier { unsigned* bar; unsigned x; volatile LAS unsigned* st; };
__device__ __forceinline__ XcdBarrier xcd_barrier_post(unsigned* bar, volatile LAS unsigned* st) {
    XcdBarrier b; b.bar = bar; b.x = xb_xcc_id(); b.st = st;
    if (threadIdx.x == 0) (void)xb_add(&bar[XB_XCNT(b.x)], 1u);
    return b;
}
__device__ __forceinline__ void xcd_barrier_complete(unsigned* bar, unsigned x, unsigned& nloc, unsigned& nx) {
    const unsigned G = gridDim.x * gridDim.y * gridDim.z;
    unsigned sum, cnt, mine, sp = 0u;
    for (;;) {
        sum = 0u; cnt = 0u; mine = 0u;
#pragma unroll
        for (unsigned j = 0; j < 16; ++j) { const unsigned c = xb_ld(&bar[XB_XCNT(j)]); sum += c; cnt += (c > 0u) ? 1u : 0u; mine = (j == x) ? c : mine; }
        if (sum == G) break;
        __builtin_amdgcn_s_sleep(1);
        if ((++sp & 255u) == 0u) { if (xb_ld(&bar[XB_TMO])) break; if (sp > XB_SPIN_CAP) { atomicAdd(&bar[XB_TMO], 1u); break; } }
    }
    nloc = mine > 0u ? mine : 1u; nx = cnt > 0u ? cnt : 1u;
}
__device__ __forceinline__ void xcd_barrier(const XcdBarrier& b) {
    asm volatile("s_waitcnt vmcnt(0)" ::: "memory");
    __syncthreads();
    if (threadIdx.x == 0) {
        unsigned* bar = b.bar;
        __builtin_amdgcn_s_waitcnt(0);
        unsigned nloc = b.st[0], nx = b.st[1];
        if (nloc == 0u) { xcd_barrier_complete(bar, b.x, nloc, nx); b.st[0] = nloc; b.st[1] = nx; }
        const unsigned old = xb_add(&bar[XB_XSUB(b.x)], 1u);
        const unsigned gen = old / nloc;
        if (old + 1u == (gen + 1u) * nloc) {
            __builtin_amdgcn_fence(__ATOMIC_RELEASE, "agent");
            asm volatile("s_waitcnt vmcnt(0)" ::: "memory");
            const unsigned og = xb_add(&bar[XB_TOP], 1u);
            const unsigned tg = og / nx;
            if (og + 1u == (tg + 1u) * nx) xb_add(&bar[XB_TOPGEN], 1u);
            else XB_SPIN(xb_ld(&bar[XB_TOPGEN]) == tg, bar);
            __builtin_amdgcn_fence(__ATOMIC_ACQUIRE, "agent");
            xb_add(&bar[XB_XGEN(b.x)], 1u);
            asm volatile("s_waitcnt vmcnt(0)" ::: "memory");
        } else {
            XB_SPIN(xb_ld(&bar[XB_XGEN(b.x)]) == gen, bar);
            __builtin_amdgcn_fence(__ATOMIC_ACQUIRE, "agent");
            asm volatile("s_waitcnt vmcnt(0)" ::: "memory");
        }
    }
    __syncthreads();
}

struct Args { const float* in[25]; float* out; unsigned char* ws; int ph_lo, ph_hi, li, pad; };
struct Frame {
    unsigned char* lds;
    unsigned char* ws; unsigned* ctl;
    int tid, lane, wave, G, bid;
    const float* const* in; float* out;
};
enum { I_X = 0, I_WIN, I_RPB, I_ARE, I_AIM, I_LDT, I_BRE, I_BIM, I_CRE, I_CIM, I_SD, I_WGLU, I_BGLU, I_WOUT, I_LN1G, I_LN1B, I_WRG, I_BRG, I_WRE, I_BRE2, I_WGATE, I_WUP, I_WDOWN, I_LN2G, I_LN2B };

__device__ __forceinline__ void load_pbase(Frame& F, int* pb) {
    if (F.tid == 0) { int acc = 0; for (int e = 0; e < NE; ++e) { pb[e] = acc; const int c = (int)__hip_atomic_load(&F.ctl[CW_CNT + e], __ATOMIC_RELAXED, __HIP_MEMORY_SCOPE_AGENT); acc += (c + 255) / 256 * 256; pb[66 + e] = c; } pb[64] = acc; }
    __syncthreads();
    for (int t = F.tid; t < MAXTILES; t += NTHR) { int e = 0; for (int j = 1; j < NE; ++j) e = (pb[j] <= t * 256) ? j : e; pb[132 + t] = e; }
    __syncthreads();
}
__device__ __forceinline__ float fp8_to_f32(unsigned w, int sel) { return sel == 0 ? __builtin_amdgcn_cvt_f32_fp8((int)w, 0) : (sel == 1 ? __builtin_amdgcn_cvt_f32_fp8((int)w, 1) : (sel == 2 ? __builtin_amdgcn_cvt_f32_fp8((int)w, 2) : __builtin_amdgcn_cvt_f32_fp8((int)w, 3))); }
__device__ __forceinline__ void p_final(Frame& F) {
    int* pb = (int*)F.lds;
    load_pbase(F, pb);
    const int* tokE = (const int*)(F.ws + WS_TOKE); const int* tokPos = (const int*)(F.ws + WS_TOKPOS);
    const bf16* Z1 = (const bf16*)(F.ws + WS_Z1); const fp8* O = (const fp8*)(F.ws + WS_O); const f32x2_t* MR = (const f32x2_t*)(F.ws + WS_MR);
    const float* tokW = (const float*)(F.ws + WS_TOKW);
    const float* g1 = F.in[I_LN1G]; const float* b1 = F.in[I_LN1B]; const float* g2 = F.in[I_LN2G]; const float* b2 = F.in[I_LN2B];
    const int lane = F.lane;
    constexpr int NT4 = 4;
    for (int tb = (F.bid * NWAVES + F.wave) * NT4; tb < T; tb += F.G * NWAVES * NT4) {
        u32x2 h[NT4][4]; unsigned a[NT4][4], b[NT4][4]; float w0[NT4], w1[NT4], mean1[NT4], rstd1[NT4];
#pragma unroll
        for (int q = 0; q < NT4; ++q) { const int t = tb + q; const int s0 = pb[tokE[2 * t]] + tokPos[2 * t], s1 = pb[tokE[2 * t + 1]] + tokPos[2 * t + 1]; w0[q] = tokW[2 * t] * 0.125f; w1[q] = tokW[2 * t + 1] * 0.125f;
            { const f32x2_t mr = MR[t]; mean1[q] = mr[0]; rstd1[q] = mr[1]; }
#pragma unroll
            for (int j = 0; j < 4; ++j) { const int c = 256 * j + lane * 4; h[q][j] = *(const u32x2*)(Z1 + (size_t)t * D + c); a[q][j] = *(const unsigned*)(O + (size_t)s0 * D + c); b[q][j] = *(const unsigned*)(O + (size_t)s1 * D + c); } }
#pragma unroll
        for (int q = 0; q < NT4; ++q) { const int t = tb + q;
            float v[16];
#pragma unroll
            for (int j = 0; j < 4; ++j) {
                const int c = 256 * j + lane * 4; const f32x4 gg = *(const f32x4*)(g1 + c), bb = *(const f32x4*)(b1 + c);
                const float z0 = __uint_as_float(h[q][j].x << 16), z1 = __uint_as_float(h[q][j].x & 0xffff0000u), z2 = __uint_as_float(h[q][j].y << 16), z3 = __uint_as_float(h[q][j].y & 0xffff0000u);
                v[4 * j + 0] = ALPHA * ((z0 - mean1[q]) * rstd1[q] * gg[0] + bb[0]) + (w0[q] * fp8_to_f32(a[q][j], 0) + w1[q] * fp8_to_f32(b[q][j], 0));
                v[4 * j + 1] = ALPHA * ((z1 - mean1[q]) * rstd1[q] * gg[1] + bb[1]) + (w0[q] * fp8_to_f32(a[q][j], 1) + w1[q] * fp8_to_f32(b[q][j], 1));
                v[4 * j + 2] = ALPHA * ((z2 - mean1[q]) * rstd1[q] * gg[2] + bb[2]) + (w0[q] * fp8_to_f32(a[q][j], 2) + w1[q] * fp8_to_f32(b[q][j], 2));
                v[4 * j + 3] = ALPHA * ((z3 - mean1[q]) * rstd1[q] * gg[3] + bb[3]) + (w0[q] * fp8_to_f32(a[q][j], 3) + w1[q] * fp8_to_f32(b[q][j], 3));
            }
            float s = 0.f;
#pragma unroll
            for (int j = 0; j < 16; ++j) s += v[j];
            const float mean = wave_sum(s) * (1.0f / D);
            float qv = 0.f;
#pragma unroll
            for (int j = 0; j < 16; ++j) { v[j] -= mean; qv += v[j] * v[j]; }
            const float rstd = rsqrtf(wave_sum(qv) * (1.0f / D) + LN_EPS);
#pragma unroll
            for (int j = 0; j < 4; ++j) {
                const int c = 256 * j + lane * 4; const f32x4 gg = *(const f32x4*)(g2 + c), bb = *(const f32x4*)(b2 + c);
                f32x4 o;
#pragma unroll
                for (int e = 0; e < 4; ++e) o[e] = v[4 * j + e] * rstd * gg[e] + bb[e];
                *(f32x4*)(F.out + (size_t)t * D + c) = o;
            }
        }
    }
}

#ifndef ENG_SP2
#define ENG_SP2 true
#endif
namespace pg8 {
typedef short bf16x8 __attribute__((ext_vector_type(8)));
constexpr int BM = 256, BK = 64, HALF = 128, HTB = HALF * BK * 2, STAGE_BYTES = 8 * HTB, NXCD = 8, WGM = 8;
__host__ __device__ __forceinline__ int lds_byte(int r, int c) { const int st = (r >> 4) * 2 + (c >> 5), rr = r & 15, cc = c & 31, ob = rr * 64 + cc * 2; return st * 1024 + (ob ^ (((ob >> 9) & 1) << 5)); }
__host__ __device__ __forceinline__ void stage_rc(int b, int& R, int& C) { const int st = b / 1024, sb = b % 1024, swz = sb ^ (((sb >> 9) & 1) << 5); R = (st >> 1) * 16 + swz / 64; C = (st & 1) * 32 + (swz % 64) / 2; }
__host__ __device__ __forceinline__ int perm32(int rho) { const int n = rho >> 4, i = rho & 15; return 8 * (i >> 2) + 4 * n + (i & 3); }
__device__ __forceinline__ unsigned cvt_pk_bf16(float lo, float hi) { unsigned r; asm volatile("v_cvt_pk_bf16_f32 %0, %1, %2" : "=v"(r) : "v"(lo), "v"(hi)); return r; }

struct Unit { int pm, pn, aux; unsigned A, B; const int* rows; unsigned rows_off; int nvalid; };
typedef int i32x4 __attribute__((ext_vector_type(4)));
template <bool F8> struct Frag { bf16x8 kh[2]; };
template <> struct Frag<true> { v8i v; };
__device__ __forceinline__ void tile_of(int L, int nM, int nN, int& pm, int& pn) {
    const int nwg = nM * nN; int wgid = L;
    { const int q = nwg / NXCD, r = nwg % NXCD, xcd = wgid % NXCD, off = wgid / NXCD; wgid = (xcd < r ? xcd * (q + 1) : r * (q + 1) + (xcd - r) * q) + off; }
    const int nig = WGM * nN, gid = wgid / nig, fm = gid * WGM, gsz = (nM - fm) < WGM ? (nM - fm) : WGM;
    pm = fm + ((wgid % nig) % gsz); pn = (wgid % nig) / gsz;
}

template <class Epi, class Sched, bool GATHER, bool F8 = false, bool SP2 = true>
__device__ __forceinline__ void gemm_phase(LAS unsigned char* lds, const unsigned char* wsbase, const int lda, const int ldb, const int nt, const Sched& S, const Epi& E) {
    const __amdgpu_buffer_rsrc_t rsrc = __builtin_amdgcn_make_buffer_rsrc((void*)wsbase, 0, 0x7fffffff, 0x00020000);
    const int tid = threadIdx.x, wid = __builtin_amdgcn_readfirstlane(tid >> 6), lane = tid & 63, wr = wid >> 2, wc = wid & 3, fr = lane & 15, fq = lane >> 4;
    unsigned voffA[2], voffB[2];
#pragma unroll
    for (int i = 0; i < 2; ++i) { int R, C; stage_rc(tid * 16 + i * 8192, R, C); const int Rb = Epi::PERM ? ((R & ~31) + perm32(R & 31)) : R;
        voffA[i] = (unsigned)(R * lda + C * 2); voffB[i] = (unsigned)(Rb * ldb + C * 2); }
    const unsigned kstep = (unsigned)(BK * 2);
    const unsigned hstepA = (unsigned)(HALF * lda), hstepB = (unsigned)(HALF * ldb);
    const unsigned ldsw = (unsigned)wid * 1024u;
    const int aoff = F8 ? lds_byte(wr * 64 + fr, fq * 16) : lds_byte(wr * 64 + fr, fq * 8), boff = F8 ? lds_byte(wc * 32 + fr, fq * 16) : lds_byte(wc * 32 + fr, fq * 8);

    LAS unsigned char* const ldsA = lds + aoff; LAS unsigned char* const ldsB = lds + 4 * HTB + boff;
#define PG8_SA(b, h) (((b) * 2 + (h)) * HTB)
#define PG8_SB(b, h) ((4 + (b) * 2 + (h)) * HTB)
#define PG8_STAGE(bufoff, gbase, voff) do { _Pragma("unroll") for (int _i = 0; _i < 2; ++_i) \
        __builtin_amdgcn_raw_ptr_buffer_load_lds(rsrc, (LAS unsigned*)(lds + (bufoff) + ldsw + _i * 8192), 16, (int)(voff)[_i], (int)(gbase), 0, 0); } while (0)
#define PG8_STAGE_A(b, h, base, vg) do { if constexpr (GATHER) { PG8_STAGE(PG8_SA(b, h), base, (vg)[h]); } else { PG8_STAGE(PG8_SA(b, h), (base) + (h) * hstepA, voffA); } } while (0)
#define PG8_RD16(base, off) (*(const LAS i32x4*)((base) + (off)))
#define PG8_LDA(dst, b, h) do { _Pragma("unroll") for (int m = 0; m < 4; ++m) { if constexpr (F8) { const i32x4 lo_ = PG8_RD16(ldsA, PG8_SA(b, h) + m * 2048), hi_ = PG8_RD16(ldsA, PG8_SA(b, h) + m * 2048 + 16); dst[m].v = __builtin_shufflevector(lo_, hi_, 0, 1, 2, 3, 4, 5, 6, 7); } \
        else { _Pragma("unroll") for (int k = 0; k < 2; ++k) dst[m].kh[k] = *(const LAS bf16x8*)(ldsA + PG8_SA(b, h) + m * 2048 + k * 1024); } } } while (0)
#define PG8_LDB(dst, b, h) do { _Pragma("unroll") for (int n = 0; n < 2; ++n) { if constexpr (F8) { const i32x4 lo_ = PG8_RD16(ldsB, ((b) * 2 + (h)) * HTB + n * 2048), hi_ = PG8_RD16(ldsB, ((b) * 2 + (h)) * HTB + n * 2048 + 16); dst[n].v = __builtin_shufflevector(lo_, hi_, 0, 1, 2, 3, 4, 5, 6, 7); } \
        else { _Pragma("unroll") for (int k = 0; k < 2; ++k) dst[n].kh[k] = *(const LAS bf16x8*)(ldsB + ((b) * 2 + (h)) * HTB + n * 2048 + k * 1024); } } } while (0)
#define PG8_MMA(ai, bj, At, Bt) do { __builtin_amdgcn_s_setprio(1); \
        if constexpr (F8) { _Pragma("unroll") for (int m = 0; m < 4; ++m) _Pragma("unroll") for (int n = 0; n < 2; ++n) \
            acc[ai][bj][m][n] = __builtin_amdgcn_mfma_scale_f32_16x16x128_f8f6f4(Bt[n].v, At[m].v, acc[ai][bj][m][n], 0, 0, 0, Epi::SCALE_B, 0, Epi::SCALE_A); } \
        else { _Pragma("unroll") for (int m = 0; m < 4; ++m) _Pragma("unroll") for (int n = 0; n < 2; ++n) _Pragma("unroll") for (int k = 0; k < 2; ++k) \
            acc[ai][bj][m][n] = __builtin_amdgcn_mfma_f32_16x16x32_bf16(Bt[n].kh[k], At[m].kh[k], acc[ai][bj][m][n], 0, 0, 0); } \
        __builtin_amdgcn_s_setprio(0); } while (0)
#define PG8_WAIT_V(n) asm volatile("s_waitcnt vmcnt(" #n ")" ::: "memory")
#define PG8_WAIT_L(n) asm volatile("s_waitcnt lgkmcnt(" #n ")" ::: "memory")
#define PG8_BAR __builtin_amdgcn_s_barrier()
#define PG8_SCHED __builtin_amdgcn_sched_barrier(0)
    Unit cur, nxt; int ui = 0;
    if (!S.next(0, cur)) return;
    f32x4 acc[2][2][4][2];
#pragma unroll
    for (int a = 0; a < 2; ++a)
#pragma unroll
        for (int b = 0; b < 2; ++b)
#pragma unroll
            for (int m = 0; m < 4; ++m)
#pragma unroll
                for (int n = 0; n < 2; ++n) acc[a][b][m][n] = (f32x4){0.f, 0.f, 0.f, 0.f};
    Frag<F8> At[4], B0[2], B1[2];
    unsigned vgc[2][2];
#define PG8_GATHER_OFFS(U) do { int tz_ = threadIdx.x; asm volatile("" : "+v"(tz_)); _Pragma("unroll") for (int i_ = 0; i_ < 2; ++i_) { int R_, C_; stage_rc(tz_ * 16 + i_ * 8192, R_, C_); \
        _Pragma("unroll") for (int h_ = 0; h_ < 2; ++h_) { const int rr_ = h_ * HALF + R_; const int tok_ = rr_ < (U).nvalid ? (U).rows[rr_] : 0; vgc[h_][i_] = (unsigned)tok_ * (unsigned)lda + (unsigned)(C_ * 2); } } } while (0)
    if constexpr (GATHER) PG8_GATHER_OFFS(cur);
    LAS int* const idxL = (LAS int*)(lds + STAGE_BYTES + 4096);
#define PG8_GATHER_OFFS_LDS(U) do { int tz_ = threadIdx.x; asm volatile("" : "+v"(tz_)); _Pragma("unroll") for (int i_ = 0; i_ < 2; ++i_) { int R_, C_; stage_rc(tz_ * 16 + i_ * 8192, R_, C_); \
        _Pragma("unroll") for (int h_ = 0; h_ < 2; ++h_) { const int rr_ = h_ * HALF + R_; const int tok_ = rr_ < (U).nvalid ? idxL[rr_] : 0; vgc[h_][i_] = (unsigned)tok_ * (unsigned)lda + (unsigned)(C_ * 2); } } } while (0)
    unsigned cA = cur.A, cB = cur.B;
    if constexpr (SP2) {
        PG8_STAGE(PG8_SB(0, 0), cB, voffB); PG8_STAGE(PG8_SB(0, 1), cB + hstepB, voffB); PG8_STAGE_A(0, 0, cA, vgc); PG8_STAGE_A(0, 1, cA, vgc);
        if (wr == 1) PG8_BAR;
        PG8_WAIT_V(2); PG8_BAR;
        PG8_STAGE(PG8_SB(1, 0), cB + kstep, voffB); PG8_STAGE_A(1, 0, cA + kstep, vgc); PG8_STAGE(PG8_SB(1, 1), cB + hstepB + kstep, voffB);
        PG8_WAIT_V(6); PG8_BAR;
    } else {
        PG8_STAGE(PG8_SB(0, 0), cB, voffB); PG8_STAGE_A(0, 0, cA, vgc); PG8_STAGE(PG8_SB(0, 1), cB + hstepB, voffB); PG8_STAGE_A(0, 1, cA, vgc);
        if (wr == 1) PG8_BAR;
        PG8_WAIT_V(4); PG8_BAR;
        PG8_STAGE(PG8_SB(1, 0), cB + kstep, voffB); PG8_STAGE_A(1, 0, cA + kstep, vgc); PG8_STAGE(PG8_SB(1, 1), cB + hstepB + kstep, voffB);
        PG8_WAIT_V(6); PG8_BAR;
    }
    for (;;) {
        const bool has_next = S.next(ui + 1, nxt);
        const unsigned nA = has_next ? nxt.A : cA, nB = has_next ? nxt.B : cB;
#pragma unroll 1
        for (int t = 0; t < nt; t += 2) {
            const bool last = (t == nt - 2);
            const unsigned a1 = cA + (unsigned)(t + 1) * kstep;
            const unsigned a2 = last ? nA : cA + (unsigned)(t + 2) * kstep, b2 = last ? nB : cB + (unsigned)(t + 2) * kstep;
            const unsigned a3 = a2 + kstep, b3 = b2 + kstep;
            if constexpr (SP2) {
            PG8_LDB(B0, 0, 0); PG8_LDB(B1, 0, 1); PG8_SCHED; PG8_LDA(At, 0, 0); PG8_STAGE_A(1, 1, a1, vgc);
            if constexpr (GATHER) { if (last && has_next) PG8_GATHER_OFFS_LDS(nxt);
                if (t == 0 && has_next && wid == 0) __builtin_amdgcn_raw_ptr_buffer_load_lds(rsrc, (LAS unsigned*)idxL, 16, (int)(lane * 16), (int)nxt.rows_off, 0, 0); }
            PG8_WAIT_V(8); PG8_WAIT_L(0); PG8_BAR; PG8_MMA(0, 0, At, B0); PG8_MMA(0, 1, At, B1); PG8_BAR; PG8_SCHED;
            PG8_LDA(At, 0, 1); PG8_STAGE(PG8_SB(0, 0), b2, voffB); PG8_STAGE(PG8_SB(0, 1), b2 + hstepB, voffB); PG8_STAGE_A(0, 0, a2, vgc);
            PG8_WAIT_V(8); PG8_WAIT_L(0); PG8_BAR; PG8_MMA(1, 0, At, B0); PG8_MMA(1, 1, At, B1); PG8_BAR; PG8_SCHED;
            PG8_LDB(B0, 1, 0); PG8_LDB(B1, 1, 1); PG8_SCHED; PG8_LDA(At, 1, 0); PG8_STAGE_A(0, 1, a2, vgc);
            PG8_WAIT_V(8); PG8_WAIT_L(0); PG8_BAR; PG8_MMA(0, 0, At, B0); PG8_MMA(0, 1, At, B1); PG8_BAR; PG8_SCHED;
            PG8_LDA(At, 1, 1); PG8_STAGE(PG8_SB(1, 0), b3, voffB); PG8_STAGE(PG8_SB(1, 1), b3 + hstepB, voffB); PG8_STAGE_A(1, 0, a3, vgc);
            PG8_WAIT_V(8); PG8_WAIT_L(0); PG8_BAR; PG8_MMA(1, 0, At, B0); PG8_MMA(1, 1, At, B1); PG8_BAR; PG8_SCHED;
            } else {
            PG8_LDB(B0, 0, 0); PG8_SCHED; PG8_LDA(At, 0, 0); PG8_STAGE_A(1, 1, a1, vgc);
            if constexpr (GATHER) { if (last && has_next) PG8_GATHER_OFFS(nxt); }
            PG8_WAIT_L(8); PG8_BAR; PG8_WAIT_L(0); PG8_MMA(0, 0, At, B0); PG8_BAR; PG8_SCHED;
            PG8_LDB(B1, 0, 1); PG8_STAGE(PG8_SB(0, 0), b2, voffB);
            PG8_BAR; PG8_WAIT_L(0); PG8_MMA(0, 1, At, B1); PG8_BAR;
            PG8_LDA(At, 0, 1); PG8_STAGE_A(0, 0, a2, vgc);
            PG8_BAR; PG8_WAIT_L(0); PG8_MMA(1, 0, At, B0); PG8_BAR; PG8_SCHED;
            PG8_STAGE(PG8_SB(0, 1), b2 + hstepB, voffB);
            PG8_WAIT_V(6); PG8_BAR; PG8_MMA(1, 1, At, B1); PG8_BAR;
            PG8_LDB(B0, 1, 0); PG8_SCHED; PG8_LDA(At, 1, 0); PG8_STAGE_A(0, 1, a2, vgc);
            PG8_WAIT_L(8); PG8_BAR; PG8_WAIT_L(0); PG8_MMA(0, 0, At, B0); PG8_BAR; PG8_SCHED;
            PG8_LDB(B1, 1, 1); PG8_STAGE(PG8_SB(1, 0), b3, voffB);
            PG8_BAR; PG8_WAIT_L(0); PG8_MMA(0, 1, At, B1); PG8_BAR;
            PG8_LDA(At, 1, 1); PG8_STAGE_A(1, 0, a3, vgc);
            PG8_BAR; PG8_WAIT_L(0); PG8_MMA(1, 0, At, B0); PG8_BAR; PG8_SCHED;
            PG8_STAGE(PG8_SB(1, 1), b3 + hstepB, voffB);
            PG8_WAIT_V(6); PG8_BAR; PG8_MMA(1, 1, At, B1); PG8_BAR;
            }
        }
        if (wr == 0) PG8_BAR;
        if constexpr (!Epi::AFTER_DRAIN) E(acc, cur, wr, wc, fr, fq);
        if (!has_next) break;
#pragma unroll
        for (int a = 0; a < 2; ++a)
#pragma unroll
            for (int b = 0; b < 2; ++b)
#pragma unroll
                for (int m = 0; m < 4; ++m)
#pragma unroll
                    for (int n = 0; n < 2; ++n) acc[a][b][m][n] = (f32x4){0.f, 0.f, 0.f, 0.f};
        cur = nxt; cA = nA; cB = nB; ++ui;
        if (wr == 1) PG8_BAR;
    }
    PG8_WAIT_V(0);
    PG8_BAR;
    if constexpr (Epi::AFTER_DRAIN) E.fused(acc, cur, wr, wc, fr, fq, lds);
#undef PG8_SA
#undef PG8_SB
#undef PG8_STAGE
#undef PG8_STAGE_A
#undef PG8_GATHER_OFFS
#undef PG8_GATHER_OFFS_LDS
#undef PG8_LDA
#undef PG8_LDB
#undef PG8_MMA
#undef PG8_RD16
#undef PG8_WAIT_V
#undef PG8_WAIT_L
#undef PG8_BAR
#undef PG8_SCHED
}
}

struct DenseSched {
    unsigned A, B; int nM, nN, G, c; unsigned a_tile, b_tile; int pm_per_grp; unsigned b_grp;
    __device__ __forceinline__ bool next(int i, pg8::Unit& u) const {
        const long L = (long)i * G + c; if (L >= (long)nM * nN) return false;
        pg8::tile_of((int)L, nM, nN, u.pm, u.pn); u.aux = u.pm / pm_per_grp;
        u.A = A + (unsigned)u.pm * a_tile; u.B = B + (unsigned)u.aux * b_grp + (unsigned)u.pn * b_tile; u.rows = nullptr; u.rows_off = 0; u.nvalid = 0; return true;
    }
};
struct PanelSched {
    unsigned A, B; int pm, nN; unsigned a_tile, b_tile; int pm_per_grp; unsigned b_grp;
    __device__ __forceinline__ bool next(int i, pg8::Unit& u) const {
        if (i >= nN) return false;
        u.pm = pm; u.pn = i; u.aux = pm / pm_per_grp;
        u.A = A + (unsigned)pm * a_tile; u.B = B + (unsigned)u.aux * b_grp + (unsigned)i * b_tile; u.rows = nullptr; u.rows_off = 0; u.nvalid = 0; return true;
    }
};
struct MoeSched {
    unsigned A, B; const int* rows; const int* pb; int nM, nN, G, c; unsigned a_tile, b_tile, b_exp, rows_ws;
    __device__ __forceinline__ bool next(int i, pg8::Unit& u) const {
        const long L = (long)i * G + c; if (L >= (long)nM * nN) return false;
        pg8::tile_of((int)L, nM, nN, u.pm, u.pn);
        const int e = __builtin_amdgcn_readfirstlane(pb[132 + u.pm]);
        u.aux = e; u.A = A + (unsigned)u.pm * a_tile; u.B = B + (unsigned)e * b_exp + (unsigned)u.pn * b_tile;
        const int off = __builtin_amdgcn_readfirstlane(u.pm * 256 - pb[e]);
        u.rows = rows ? rows + (size_t)e * ECAP + off : nullptr; u.rows_off = rows_ws + ((unsigned)e * ECAP + (unsigned)off) * 4u; u.nvalid = __builtin_amdgcn_readfirstlane(pb[66 + e] - off); return true;
    }
};

#define EPI_ROWS_COLS_PERM() const int row0 = u.pm * 256 + wr * 64 + fr, col0 = u.pn * 256 + wc * 32 + 8 * fq
__device__ __forceinline__ u32x4 pack8(const f32x4 v0, const f32x4 v1) { u32x4 w; w.x = pg8::cvt_pk_bf16(v0[0], v0[1]); w.y = pg8::cvt_pk_bf16(v0[2], v0[3]); w.z = pg8::cvt_pk_bf16(v1[0], v1[1]); w.w = pg8::cvt_pk_bf16(v1[2], v1[3]); return w; }
struct EpiProj {
    static constexpr bool PERM = true, AFTER_DRAIN = false;
    bf16 *Q, *UA;
    __device__ __forceinline__ void operator()(const f32x4 (&acc)[2][2][4][2], const pg8::Unit& u, int wr, int wc, int fr, int fq) const {
        EPI_ROWS_COLS_PERM();
        const int sel = u.pn >> 1;
        const float sc = sel == 0 ? 0.125f : 1.0f;
#pragma unroll
        for (int ai = 0; ai < 2; ++ai)
#pragma unroll
            for (int m = 0; m < 4; ++m) { const int r = row0 + ai * 128 + m * 16;
#pragma unroll
                for (int bj = 0; bj < 2; ++bj) { const int c = col0 + bj * 128; const u32x4 w = pack8(acc[ai][bj][m][0] * sc, acc[ai][bj][m][1] * sc);
                    if (sel < 3) { bf16* base = Q + (size_t)sel * ((WS_K - WS_Q) / 2); *(u32x4*)(base + (size_t)r * AW + (c & 511)) = w; }
                    else { const int cc = c - 1536, g = cc >> 4; *(u32x4*)(UA + ((size_t)g * NBLK + (r >> 5)) * UAW + (r & 31) * SC + (cc & 15)) = w; } } }
    }
};
struct EpiGlu {
    static constexpr bool PERM = true, AFTER_DRAIN = false;
    const bf16* G; bf16* MIX; const float* bias;
    __device__ __forceinline__ void operator()(const f32x4 (&acc)[2][2][4][2], const pg8::Unit& u, int wr, int wc, int fr, int fq) const {
        EPI_ROWS_COLS_PERM();
        u32x4 gwv[2][4][2];
#pragma unroll
        for (int ai = 0; ai < 2; ++ai)
#pragma unroll
            for (int m = 0; m < 4; ++m)
#pragma unroll
                for (int bj = 0; bj < 2; ++bj) gwv[ai][m][bj] = *(const u32x4*)(G + (size_t)(row0 + ai * 128 + m * 16) * SW + col0 + bj * 128);
#pragma unroll
        for (int bj = 0; bj < 2; ++bj) { const int c = col0 + bj * 128; const f32x4 b0 = *(const f32x4*)(bias + c), b1 = *(const f32x4*)(bias + c + 4);
#pragma unroll
            for (int ai = 0; ai < 2; ++ai)
#pragma unroll
                for (int m = 0; m < 4; ++m) { const int r = row0 + ai * 128 + m * 16;
                    const u32x4 gw = gwv[ai][m][bj]; f32x4 o0, o1;
#pragma unroll
                    for (int e = 0; e < 2; ++e) { o0[2 * e] = __uint_as_float(gw[e] << 16) * sigmoidf_(acc[ai][bj][m][0][2 * e] + b0[2 * e]); o0[2 * e + 1] = __uint_as_float(gw[e] & 0xffff0000u) * sigmoidf_(acc[ai][bj][m][0][2 * e + 1] + b0[2 * e + 1]);
                        o1[2 * e] = __uint_as_float(gw[2 + e] << 16) * sigmoidf_(acc[ai][bj][m][1][2 * e] + b1[2 * e]); o1[2 * e + 1] = __uint_as_float(gw[2 + e] & 0xffff0000u) * sigmoidf_(acc[ai][bj][m][1][2 * e + 1] + b1[2 * e + 1]); }
                    *(u32x4*)(MIX + (size_t)r * D + AW + c) = pack8(o0, o1); } }
    }
};
struct EpiWout {
    static constexpr bool PERM = true, AFTER_DRAIN = false;
    bf16* Z1; f32x2_t* STATS;
    __device__ __forceinline__ void operator()(const f32x4 (&acc)[2][2][4][2], const pg8::Unit& u, int wr, int wc, int fr, int fq) const {
        EPI_ROWS_COLS_PERM();
        u32x4 xw[2][4][2];
#pragma unroll
        for (int ai = 0; ai < 2; ++ai)
#pragma unroll
            for (int m = 0; m < 4; ++m)
#pragma unroll
                for (int bj = 0; bj < 2; ++bj) xw[ai][m][bj] = *(const u32x4*)(Z1 + (size_t)(row0 + ai * 128 + m * 16) * D + col0 + bj * 128);
#pragma unroll
        for (int ai = 0; ai < 2; ++ai)
#pragma unroll
            for (int m = 0; m < 4; ++m) { const int r = row0 + ai * 128 + m * 16; float s1 = 0.f, s2 = 0.f;
#pragma unroll
                for (int bj = 0; bj < 2; ++bj) { const int c = col0 + bj * 128; const u32x4 w = xw[ai][m][bj]; f32x4 x0, x1;
                    x0[0] = __uint_as_float(w[0] << 16); x0[1] = __uint_as_float(w[0] & 0xffff0000u); x0[2] = __uint_as_float(w[1] << 16); x0[3] = __uint_as_float(w[1] & 0xffff0000u);
                    x1[0] = __uint_as_float(w[2] << 16); x1[1] = __uint_as_float(w[2] & 0xffff0000u); x1[2] = __uint_as_float(w[3] << 16); x1[3] = __uint_as_float(w[3] & 0xffff0000u);
                    const f32x4 z0 = x0 * ALPHA + acc[ai][bj][m][0], z1 = x1 * ALPHA + acc[ai][bj][m][1];
#pragma unroll
                    for (int e = 0; e < 4; ++e) { s1 += z0[e] + z1[e]; s2 += z0[e] * z0[e] + z1[e] * z1[e]; }
                    *(u32x4*)(Z1 + (size_t)r * D + c) = pack8(z0, z1); }
                s1 = xadd32(xadd16(s1)); s2 = xadd32(xadd16(s2));
                if (fq == 0) { f32x2_t w; w[0] = s1; w[1] = s2; STATS[(size_t)(u.pn * 4 + wc) * T + r] = w; } }
    }
};
struct EpiGateUp {
    static constexpr bool PERM = true, AFTER_DRAIN = false; static constexpr int SCALE_A = 0x7f7f7f7f, SCALE_B = 0x7f7f7f7f;
    fp8* HID;
    __device__ __forceinline__ void operator()(const f32x4 (&acc)[2][2][4][2], const pg8::Unit& u, int wr, int wc, int fr, int fq) const {
        const int row0 = u.pm * 256 + wr * 64 + fr, col0 = u.pn * 128 + wc * 32 + 8 * fq;
#pragma unroll
        for (int ai = 0; ai < 2; ++ai)
#pragma unroll
            for (int m = 0; m < 4; ++m) { const int r = row0 + ai * 128 + m * 16; f32x4 o[2];
#pragma unroll
                for (int n = 0; n < 2; ++n)
#pragma unroll
                    for (int e = 0; e < 4; ++e) { const float gt = acc[ai][0][m][n][e] * 0.03125f; o[n][e] = gt * sigmoidf_(gt) * (acc[ai][1][m][n][e] * 0.03125f); }
                u32x2 w; w.x = pk4_fp8(o[0][0], o[0][1], o[0][2], o[0][3]); w.y = pk4_fp8(o[1][0], o[1][1], o[1][2], o[1][3]);
                *(u32x2*)(HID + (size_t)r * DE + col0) = w; }
    }
};
struct EpiDown {
    static constexpr bool PERM = true, AFTER_DRAIN = false; static constexpr int SCALE_A = 0x7f7f7f7f, SCALE_B = 0x7f7f7f7f;
    fp8* O;
    __device__ __forceinline__ void operator()(const f32x4 (&acc)[2][2][4][2], const pg8::Unit& u, int wr, int wc, int fr, int fq) const {
        EPI_ROWS_COLS_PERM();
#pragma unroll
        for (int ai = 0; ai < 2; ++ai)
#pragma unroll
            for (int m = 0; m < 4; ++m) { const int r = row0 + ai * 128 + m * 16;
#pragma unroll
                for (int bj = 0; bj < 2; ++bj) { const f32x4 a = acc[ai][bj][m][0] * 0.25f, b = acc[ai][bj][m][1] * 0.25f; u32x2 w; w.x = pk4_fp8(a[0], a[1], a[2], a[3]); w.y = pk4_fp8(b[0], b[1], b[2], b[3]);
                    *(u32x2*)(O + (size_t)r * D + col0 + bj * 128) = w; } }
    }
};

struct CvtItem { const float* W; bf16* WT; int ldw, ldt, k0, n0, drow0; };
__device__ __forceinline__ void cvt_load(const CvtItem& c, f32x4 (&v)[16], int lane) {
    const int rq = lane >> 4, cq = (lane & 15) * 4;
#pragma unroll
    for (int i = 0; i < 16; ++i) v[i] = *(const f32x4*)(c.W + (size_t)(c.k0 + 8 * (i >> 1) + 2 * rq + (i & 1)) * c.ldw + c.n0 + cq);
}
__device__ __forceinline__ void cvt_store(const CvtItem& c, const f32x4 (&v)[16], LAS unsigned char* tile, int lane) {
    const int rq = lane >> 4, l15 = lane & 15, sw = (l15 & 7) << 2;
#pragma unroll
    for (int m = 0; m < 8; ++m)
#pragma unroll
        for (int e = 0; e < 4; ++e) *(LAS unsigned*)(tile + (4 * l15 + e) * 128 + (((4 * m + rq) ^ sw) << 2)) = pk2(v[2 * m][e], v[2 * m + 1][e]);
    asm volatile("s_waitcnt lgkmcnt(0)" ::: "memory");
    const int ch = lane & 7;
#pragma unroll
    for (int j = 0; j < 8; ++j) { const int n = (lane >> 3) + 8 * j;
        const u32x4 o = *(const LAS u32x4*)(tile + n * 128 + ((ch ^ ((n >> 2) & 7)) << 4));
        *(u32x4*)(c.WT + (size_t)(c.drow0 + n) * c.ldt + c.k0 + 8 * ch) = o; }
    asm volatile("s_waitcnt lgkmcnt(0)" ::: "memory");
}
struct CvtItem8 { const float* W; fp8* WT; int ldw, ldt, k0, n0, drow0; };
__device__ __forceinline__ void cvt8_load(const CvtItem8& c, f32x4 (&v)[16], int lane) {
    const int rq = lane >> 4, cq = (lane & 15) * 4;
#pragma unroll
    for (int i = 0; i < 16; ++i) v[i] = *(const f32x4*)(c.W + (size_t)(c.k0 + 16 * (i >> 2) + 4 * rq + (i & 3)) * c.ldw + c.n0 + cq);
}
__device__ __forceinline__ void cvt8_store(const CvtItem8& c, const f32x4 (&v)[16], LAS unsigned char* tile, int lane) {
    const int rq = lane >> 4, l15 = lane & 15, sw = l15 & 3;
#pragma unroll
    for (int m = 0; m < 4; ++m)
#pragma unroll
        for (int e = 0; e < 4; ++e) *(LAS unsigned*)(tile + (4 * l15 + e) * 64 + ((m ^ sw) << 4) + (rq << 2)) = pk4_fp8(v[4 * m][e] * 32.f, v[4 * m + 1][e] * 32.f, v[4 * m + 2][e] * 32.f, v[4 * m + 3][e] * 32.f);
    asm volatile("s_waitcnt lgkmcnt(0)" ::: "memory");
    const int ch = lane & 3;
#pragma unroll
    for (int j = 0; j < 4; ++j) { const int n = (lane >> 2) + 16 * j;
        const u32x4 o = *(const LAS u32x4*)(tile + n * 64 + ((ch ^ ((n >> 2) & 3)) << 4));
        *(u32x4*)(c.WT + (size_t)(c.drow0 + n) * c.ldt + c.k0 + 16 * ch) = o; }
    asm volatile("s_waitcnt lgkmcnt(0)" ::: "memory");
}
__device__ __forceinline__ void p0_item(const float* W, int ldw, bf16* WT, int ldt, int k0, int n0, int drow0, LAS unsigned char* tile, int lane) {
    CvtItem c; c.W = W; c.WT = WT; c.ldw = ldw; c.ldt = ldt; c.k0 = k0; c.n0 = n0; c.drow0 = drow0;
    f32x4 v[16]; cvt_load(c, v, lane); cvt_store(c, v, tile, lane);
}
__device__ __forceinline__ void p0_prologue(Frame& F) {
    LAS unsigned char* scr = (LAS unsigned char*)F.lds + F.wave * 16896;
    const int gw = F.bid * NWAVES + F.wave, NGW = F.G * NWAVES, lane = F.lane;
    bf16* WIN_T = (bf16*)(F.ws + WS_WIN_T); bf16* WGLU_T = (bf16*)(F.ws + WS_WGLU_T); bf16* WOUT_T = (bf16*)(F.ws + WS_WOUT_T); bf16* XB = (bf16*)(F.ws + WS_XB);
    constexpr int I_IN = 16 * 32, I_GL = 8 * 8, I_OUT = 16 * 16, NITEMS = I_IN + I_GL + I_OUT;
    for (int it = gw; it < NITEMS; it += NGW) {
        int r = it;
        if (r < I_IN) { const int kb = r / 32, nb = r % 32; p0_item(F.in[I_WIN], INW, WIN_T, D, kb * 64, nb * 64, nb * 64, scr, lane); continue; } r -= I_IN;
        if (r < I_GL) { const int kb = r / 8, nb = r % 8; p0_item(F.in[I_WGLU], SW, WGLU_T, SW, kb * 64, nb * 64, nb * 64, scr, lane); continue; } r -= I_GL;
        { const int kb = r / 16, nb = r % 16; p0_item(F.in[I_WOUT], D, WOUT_T, D, kb * 64, nb * 64, nb * 64, scr, lane); }
    }
    { bf16* WRT = (bf16*)(F.ws + WS_WR_T);
      for (int i = F.bid * NTHR + F.tid; i < 72 * D; i += F.G * NTHR) { const int n = i >> 10, k = i & 1023; WRT[i] = f2bf(n < 64 ? F.in[I_WRE][(size_t)k * NE + n] : F.in[I_WRG][(size_t)k * NEG + n - 64]); } }
    const float* x = F.in[I_X];
    int* qslot = (int*)(F.lds + 8 * 16896);
    __syncthreads();
    if (F.tid == 0) qslot[0] = (int)__hip_atomic_fetch_add(&F.ctl[CW_XQ], 1u, __ATOMIC_RELAXED, __HIP_MEMORY_SCOPE_AGENT);
    __syncthreads();
    for (int par = 0;; par ^= 1) {
        const int ch = qslot[par];
        if (ch >= T / 32) break;
        if (F.tid == 0) qslot[par ^ 1] = (int)__hip_atomic_fetch_add(&F.ctl[CW_XQ], 1u, __ATOMIC_RELAXED, __HIP_MEMORY_SCOPE_AGENT);
        const size_t base = (size_t)ch * 32 * D + (size_t)F.tid * 8;
        f32x4 a[8], b2[8];
#pragma unroll
        for (int j = 0; j < 8; ++j) { a[j] = *(const f32x4*)(x + base + j * 4096); b2[j] = *(const f32x4*)(x + base + j * 4096 + 4); }
#pragma unroll
        for (int j = 0; j < 8; ++j) { u32x4 o; o.x = pk2(a[j][0], a[j][1]); o.y = pk2(a[j][2], a[j][3]); o.z = pk2(b2[j][0], b2[j][1]); o.w = pk2(b2[j][2], b2[j][3]); *(u32x4*)(XB + base + j * 4096) = o; }
        __syncthreads();
    }
}
__device__ __forceinline__ CvtItem8 moe_item(Frame& F, int it) {
    constexpr int I_EXP = 16 * 8 + 16 * 8 + 8 * 16;
    fp8* WGU = (fp8*)(F.ws + WS_WGU_T); fp8* WDN = (fp8*)(F.ws + WS_WDN_T);
    const int e = it / I_EXP; int r = it - e * I_EXP; CvtItem8 c;
    if (r < 256) { const bool up = r >= 128; r &= 127; const int kb = r / 8, nb = r % 8, n0 = nb * 64;
        c.W = (up ? F.in[I_WUP] : F.in[I_WGATE]) + (size_t)e * D * DE; c.ldw = DE; c.WT = WGU + (size_t)e * 1024 * D; c.ldt = D; c.k0 = kb * 64; c.n0 = n0; c.drow0 = 256 * (n0 >> 7) + (up ? 128 : 0) + (n0 & 127); }
    else { r -= 256; const int kb = r / 16, nb = r % 16; c.W = F.in[I_WDOWN] + (size_t)e * DE * D; c.ldw = D; c.WT = WDN + (size_t)e * D * DE; c.ldt = DE; c.k0 = kb * 64; c.n0 = nb * 64; c.drow0 = nb * 64; }
    return c;
}

constexpr int MOE_NGRP = NE * (16 * 8 + 16 * 8 + 8 * 16) / 8;
__device__ __forceinline__ void moe_fill_group(Frame& F, int grp) {
    LAS unsigned char* scr = (LAS unsigned char*)F.lds + F.wave * 16896;
    const CvtItem8 c = moe_item(F, grp * 8 + F.wave);
    f32x4 v[16]; cvt8_load(c, v, F.lane); cvt8_store(c, v, scr, F.lane);
}
__device__ __forceinline__ void moe_drain(Frame& F) {
    LAS int* slot = (LAS int*)((LAS unsigned char*)F.lds + 8 * 16896);
    for (;;) {
        __syncthreads();
        if (F.tid == 0) slot[0] = (int)__hip_atomic_fetch_add(&F.ctl[CW_MQ], 1u, __ATOMIC_RELAXED, __HIP_MEMORY_SCOPE_AGENT);
        __syncthreads();
        const int grp = slot[0];
        if (grp >= MOE_NGRP) break;
        moe_fill_group(F, grp);
    }
    __syncthreads();
}
__device__ __forceinline__ void xcd_barrier_fill(const XcdBarrier& b, Frame& F) {
    asm volatile("s_waitcnt vmcnt(0)" ::: "memory");
    __syncthreads();
    volatile LAS int* role = (volatile LAS int*)((LAS unsigned char*)F.lds + 8 * 16896 + 64);
    unsigned* bar = b.bar;
    if (threadIdx.x == 0) {
        __builtin_amdgcn_s_waitcnt(0);
        unsigned nloc = b.st[0], nx = b.st[1];
        if (nloc == 0u) { xcd_barrier_complete(bar, b.x, nloc, nx); b.st[0] = nloc; b.st[1] = nx; }
        const unsigned old = xb_add(&bar[XB_XSUB(b.x)], 1u);
        const unsigned gen = old / nloc;
        const bool leader = (old + 1u == (gen + 1u) * nloc);
        role[0] = leader ? 1 : 0; role[1] = (int)gen;
        if (leader) {
            __builtin_amdgcn_fence(__ATOMIC_RELEASE, "agent");
            asm volatile("s_waitcnt vmcnt(0)" ::: "memory");
            const unsigned og = xb_add(&bar[XB_TOP], 1u);
            const unsigned tg = og / nx;
            if (og + 1u == (tg + 1u) * nx) xb_add(&bar[XB_TOPGEN], 1u);
            else XB_SPIN(xb_ld(&bar[XB_TOPGEN]) == tg, bar);
            __builtin_amdgcn_fence(__ATOMIC_ACQUIRE, "agent");
            xb_add(&bar[XB_XGEN(b.x)], 1u);
            asm volatile("s_waitcnt vmcnt(0)" ::: "memory");
        }
    }
    __syncthreads();
    if (role[0] == 0) {
        unsigned spins = 0;
        for (;;) {
            if (threadIdx.x == 0) {
                const unsigned gen = (unsigned)role[1];
                bool done = xb_ld(&bar[XB_XGEN(b.x)]) != gen;
                if (!done && ((++spins & 1023u) == 0u)) { if (xb_ld(&bar[XB_TMO])) done = true; else if (spins > XB_SPIN_CAP) { atomicAdd(&bar[XB_TMO], 1u); done = true; } }
                int grp = -1;
                if (!done) {
                    const unsigned nloc = b.st[0], nx = b.st[1];
                    const unsigned loc = xb_ld(&bar[XB_XSUB(b.x)]) - gen * nloc, top = xb_ld(&bar[XB_TOP]) - gen * nx;
                    if ((loc < nloc || top + 1u < nx) && xb_ld(&F.ctl[CW_MQ]) < (unsigned)MOE_NGRP) { const unsigned g_ = xb_add(&F.ctl[CW_MQ], 1u); if (g_ < (unsigned)MOE_NGRP) grp = (int)g_; }
                }
                role[2] = done ? 1 : 0; role[3] = grp;
            }
            __syncthreads();
            const int done = role[2], grp = role[3];
            if (done) break;
            if (grp >= 0) moe_fill_group(F, grp); else __builtin_amdgcn_s_sleep(4);
            __syncthreads();
        }
        if (threadIdx.x == 0) { __builtin_amdgcn_fence(__ATOMIC_ACQUIRE, "agent"); asm volatile("s_waitcnt vmcnt(0)" ::: "memory"); }
    }
    __syncthreads();
}

__device__ __forceinline__ void p0_s5tables_group(Frame& F, int g, int q) {
    float* PWr = (float*)F.lds;
    float* PWi = PWr + 2 * 64 * 33;
    float* BBr = PWi + 2 * 64 * 33;
    float* BBi = BBr + 2 * 64 * 16;
    float* Cr = BBi + 2 * 64 * 16;
    float* Ci = Cr + 2 * 16 * 64;
    float* KL = Ci + 2 * 16 * 64;
    float* C2r = KL + 64 * 257;
    float* C2i = C2r + 2 * 16 * 64;
    const int tid = F.tid;
    __syncthreads();
    if (tid < 128) {
        const int d = tid >> 6, p = tid & 63;
        const float ar = F.in[I_ARE][(d * SG + g) * SP + p], ai = F.in[I_AIM][(d * SG + g) * SP + p];
        const float dt = expf(F.in[I_LDT][d * SG + g]);
        const float mag = expf(ar * dt), lr = mag * cosf(ai * dt), li = mag * sinf(ai * dt);
        float pr = 1.0f, pi = 0.0f;
        for (int j = 0; j <= 32; ++j) { PWr[(d * 64 + p) * 33 + j] = pr; PWi[(d * 64 + p) * 33 + j] = pi; const float nr = pr * lr - pi * li, ni = pr * li + pi * lr; pr = nr; pi = ni; }
        const float den = ar * ar + ai * ai;
        const float zr = ((lr - 1.0f) * ar + li * ai) / den, zi = (li * ar - (lr - 1.0f) * ai) / den;
        for (int c = 0; c < SC; ++c) {
            const float br = F.in[I_BRE][((size_t)(d * SG + g) * SP + p) * SC + c], bi = F.in[I_BIM][((size_t)(d * SG + g) * SP + p) * SC + c];
            BBr[(d * 64 + p) * 16 + c] = zr * br - zi * bi; BBi[(d * 64 + p) * 16 + c] = zr * bi + zi * br;
            const float crv = F.in[I_CRE][((size_t)(d * SG + g) * SC + c) * SP + p], civ = F.in[I_CIM][((size_t)(d * SG + g) * SC + c) * SP + p];
            Cr[(d * 64 + p) * 16 + c] = crv; Ci[(d * 64 + p) * 16 + c] = civ; C2r[(d * 16 + c) * 64 + p] = crv; C2i[(d * 16 + c) * 64 + p] = civ;
        }
    }
    __syncthreads();
    for (int idx = tid; idx < 1024; idx += NTHR) {
        const int d = idx >> 9, j = (idx >> 4) & 31, c = idx & 15;
        if (d == 0 ? (j > 8 * q + 7) : (j > 31 - 8 * q)) continue;
        float acc[16];
#pragma unroll
        for (int q = 0; q < 16; ++q) acc[q] = 0.f;
        for (int p = 0; p < 64; ++p) {
            const float cr = Cr[(d * 64 + p) * 16 + c], ci = Ci[(d * 64 + p) * 16 + c], pr = PWr[(d * 64 + p) * 33 + j], pi = PWi[(d * 64 + p) * 33 + j];
            const float mr = cr * pr - ci * pi, mi = cr * pi + ci * pr;
            const f32x4* br4 = (const f32x4*)(BBr + (d * 64 + p) * 16); const f32x4* bi4 = (const f32x4*)(BBi + (d * 64 + p) * 16);
#pragma unroll
            for (int q = 0; q < 4; ++q) { const f32x4 br = br4[q], bi = bi4[q];
#pragma unroll
                for (int e = 0; e < 4; ++e) acc[4 * q + e] += mr * br[e] - mi * bi[e]; }
        }
#pragma unroll
        for (int q = 0; q < 16; ++q) KL[(d * 32 + j) * 257 + c * 16 + q] = acc[q];
    }
    __syncthreads();
    for (int part = 2 * q; part < 2 * q + 2; ++part) {
    bf16* KY = (bf16*)(F.ws + WS_KY) + (size_t)g * 512 * UAW;
    for (int o = tid; o < 64 * 64; o += NTHR) {
        const int rr = o >> 6, k0 = (o & 63) * 8, n = 64 * part + rr, t = n >> 4, c = n & 15;
        float v[8];
#pragma unroll
        for (int e = 0; e < 8; ++e) {
            const int k = k0 + e, sI = k >> 4, c2 = k & 15;
            float val = (sI <= t ? KL[(0 * 32 + (t - sI)) * 257 + c * 16 + c2] : 0.f) + (sI >= t ? KL[(1 * 32 + (sI - t)) * 257 + c * 16 + c2] : 0.f);
            if (sI == t && c == c2) val += F.in[I_SD][g * SC + c];
            v[e] = val;
        }
        u32x4 w; w.x = pk2(v[0], v[1]); w.y = pk2(v[2], v[3]); w.z = pk2(v[4], v[5]); w.w = pk2(v[6], v[7]);
        *(u32x4*)(KY + (size_t)n * UAW + k0) = w;
    }
    for (int o = tid; o < 64 * 4 * 64; o += NTHR) {
        const int p = o & 63, seg = (o >> 6) & 3, rr = o >> 8, n = 64 * part + rr, t = n >> 4, c = n & 15, d = seg >> 1, im = seg & 1, j = d == 0 ? t + 1 : 32 - t;
        const float cr = C2r[(d * 16 + c) * 64 + p], ci = C2i[(d * 16 + c) * 64 + p], pr = PWr[(d * 64 + p) * 33 + j], pi = PWi[(d * 64 + p) * 33 + j];
        KY[(size_t)n * UAW + 512 + seg * 64 + p] = f2bf(im ? -(cr * pi + ci * pr) : (cr * pr - ci * pi));
    }
    bf16* WE = (bf16*)(F.ws + WS_WE) + (size_t)g * 256 * 512;
    for (int o = tid; o < 32 * 64; o += NTHR) {
        const int rr = o >> 6, k0 = (o & 63) * 8, n = 32 * part + rr, seg = n >> 6, p = n & 63, d = seg >> 1, im = seg & 1;
        float v[8];
#pragma unroll
        for (int e = 0; e < 8; ++e) { const int k = k0 + e, sI = k >> 4, c2 = k & 15, j = d == 0 ? 31 - sI : sI;
            const float pr = PWr[(d * 64 + p) * 33 + j], pi = PWi[(d * 64 + p) * 33 + j], br = BBr[(d * 64 + p) * 16 + c2], bi = BBi[(d * 64 + p) * 16 + c2];
            v[e] = im ? (pr * bi + pi * br) : (pr * br - pi * bi); }
        u32x4 w; w.x = pk2(v[0], v[1]); w.y = pk2(v[2], v[3]); w.z = pk2(v[4], v[5]); w.w = pk2(v[6], v[7]);
        *(u32x4*)(WE + (size_t)n * 512 + k0) = w;
    }
    }
    if (q == 0 && tid < 128) { const int d = tid >> 6, p = tid & 63; float* L = (float*)(F.ws + WS_S5TAB) + ((size_t)(g * 2 + d) * 64 + p) * 2; L[0] = PWr[(d * 64 + p) * 33 + 32]; L[1] = PWi[(d * 64 + p) * 33 + 32]; }
    __syncthreads();
}
__device__ __forceinline__ void p0_s5tables(Frame& F) { for (int it = F.bid; it < SG * 4; it += F.G) p0_s5tables_group(F, it >> 2, it & 3); }

struct EpiS5E {
    static constexpr bool PERM = false, AFTER_DRAIN = false;
    float* E;
    __device__ __forceinline__ void operator()(const f32x4 (&acc)[2][2][4][2], const pg8::Unit& u, int wr, int wc, int fr, int fq) const {
        const int row0 = u.pm * 256 + wr * 64 + fr, col0 = wc * 32 + 4 * fq;
#pragma unroll
        for (int ai = 0; ai < 2; ++ai)
#pragma unroll
            for (int m = 0; m < 4; ++m) { float* rowp = E + (size_t)(row0 + ai * 128 + m * 16) * 256 + col0;
#pragma unroll
                for (int bj = 0; bj < 2; ++bj)
#pragma unroll
                    for (int n = 0; n < 2; ++n) *(f32x4*)(rowp + bj * 128 + n * 16) = acc[ai][bj][m][n]; }
    }
};
struct EpiS5Y {
    static constexpr bool PERM = true, AFTER_DRAIN = false;
    bf16* G;
    __device__ __forceinline__ void operator()(const f32x4 (&acc)[2][2][4][2], const pg8::Unit& u, int wr, int wc, int fr, int fq) const {
        EPI_ROWS_COLS_PERM();
#pragma unroll
        for (int ai = 0; ai < 2; ++ai)
#pragma unroll
            for (int m = 0; m < 4; ++m) { const int r = row0 + ai * 128 + m * 16, g = r >> 11, blk = r & 2047;
#pragma unroll
                for (int bj = 0; bj < 2; ++bj) { const int c = col0 + bj * 128, t = c >> 4, ch = c & 15; f32x4 o0, o1;
#pragma unroll
                    for (int e = 0; e < 4; ++e) { o0[e] = gelu_tanh(acc[ai][bj][m][0][e]); o1[e] = gelu_tanh(acc[ai][bj][m][1][e]); }
                    *(u32x4*)(G + ((size_t)blk * TB + t) * SW + g * SC + ch) = pack8(o0, o1); } }
    }
};

struct EpiS5EScan {
    static constexpr bool PERM = false, AFTER_DRAIN = true;
    bf16* UA; const float* L32;
    __device__ __forceinline__ void fused(const f32x4 (&acc)[2][2][4][2], const pg8::Unit& u, int wr, int wc, int fr, int fq, LAS unsigned char* lds) const {
        LAS float* Eb = (LAS float*)lds;
        const int g = u.pm >> 3, p = threadIdx.x & 63;
        const size_t rowbase = (size_t)u.pm * 256;
#pragma unroll
        for (int d = 0; d < 2; ++d) {
#pragma unroll
            for (int ai = 0; ai < 2; ++ai)
#pragma unroll
                for (int m = 0; m < 4; ++m)
#pragma unroll
                    for (int n = 0; n < 2; ++n) *(LAS f32x4*)(Eb + (ai * 128 + wr * 64 + m * 16 + fr) * 128 + wc * 32 + n * 16 + 4 * fq) = acc[ai][d][m][n];
            __syncthreads();
            if (threadIdx.x < 64) {
                const float lr = L32[((size_t)(g * 2 + d) * 64 + p) * 2], li = L32[((size_t)(g * 2 + d) * 64 + p) * 2 + 1];
                float hr = 0.f, hi = 0.f;
                for (int k0 = 0; k0 < 256; k0 += 8) {
                    float er[8], ei[8];
#pragma unroll
                    for (int i = 0; i < 8; ++i) { const int k = d == 0 ? k0 + i : 255 - (k0 + i); er[i] = Eb[k * 128 + p]; ei[i] = Eb[k * 128 + 64 + p]; }
#pragma unroll
                    for (int i = 0; i < 8; ++i) { const int k = d == 0 ? k0 + i : 255 - (k0 + i);
                        bf16* o = UA + (rowbase + k) * UAW + 512 + d * 128; o[p] = f2bf(hr); o[64 + p] = f2bf(hi);
                        const float nr = lr * hr - li * hi + er[i], ni = lr * hi + li * hr + ei[i]; hr = nr; hi = ni; }
                }
            }
            __syncthreads();
        }
    }
};
__device__ __forceinline__ void f_s5e(Frame& F) {
    DenseSched S{(unsigned)WS_UA, (unsigned)WS_WE, T / 256, 1, F.G, F.bid, 256u * UAW * 2, 0u, 8, 256u * 512 * 2};
    if (F.G >= T / 256) {
        EpiS5EScan E{(bf16*)(F.ws + WS_UA), (const float*)(F.ws + WS_S5TAB)};
        pg8::gemm_phase<EpiS5EScan, DenseSched, false>((LAS unsigned char*)F.lds, F.ws, UAW * 2, 512 * 2, 512 / 64, S, E);
        if (F.bid < T / 256) {
            int pm, pn; pg8::tile_of(F.bid, T / 256, 1, pm, pn);
            asm volatile("s_waitcnt vmcnt(0)" ::: "memory");
            __syncthreads();
            PanelSched S2{(unsigned)WS_UA, (unsigned)WS_KY, pm, 2, 256u * UAW * 2, 256u * UAW * 2, 8, 512u * UAW * 2};
            EpiS5Y E2{(bf16*)(F.ws + WS_G)};
            pg8::gemm_phase<EpiS5Y, PanelSched, false, false, ENG_SP2>((LAS unsigned char*)F.lds, F.ws, UAW * 2, UAW * 2, UAW / 64, S2, E2);
        }
    } else {
        EpiS5E E{(float*)(F.ws + WS_E)};
        pg8::gemm_phase<EpiS5E, DenseSched, false>((LAS unsigned char*)F.lds, F.ws, UAW * 2, 512 * 2, 512 / 64, S, E);
    }
}
__device__ __forceinline__ void f_s5y(Frame& F) {
    DenseSched S{(unsigned)WS_UA, (unsigned)WS_KY, T / 256, 2, F.G, F.bid, 256u * UAW * 2, 256u * UAW * 2, 8, 512u * UAW * 2};
    EpiS5Y E{(bf16*)(F.ws + WS_G)};
    pg8::gemm_phase<EpiS5Y, DenseSched, false, false, ENG_SP2>((LAS unsigned char*)F.lds, F.ws, UAW * 2, UAW * 2, UAW / 64, S, E);
}
__device__ __forceinline__ void f_s5scan(Frame& F) {
    const float* E = (const float*)(F.ws + WS_E); bf16* UA = (bf16*)(F.ws + WS_UA); const float* L32 = (const float*)(F.ws + WS_S5TAB);
    const int per = (NBATCH * SG * 2 * SP + F.G - 1) / F.G;
    if (F.tid >= per) return;
    const int id = F.bid * per + F.tid; if (id >= NBATCH * SG * 2 * SP) return;
    const int p = id & 63, d = (id >> 6) & 1, g = (id >> 7) & 31, b = id >> 12;
    const float lr = L32[((size_t)(g * 2 + d) * 64 + p) * 2], li = L32[((size_t)(g * 2 + d) * 64 + p) * 2 + 1];
    float hr = 0.f, hi = 0.f;
    const size_t rowbase = (size_t)g * NBLK + (size_t)b * 256;
    const int colr = d * 128 + p, coli = colr + 64;
    for (int k0 = 0; k0 < 256; k0 += 8) {
        float er[8], ei[8];
#pragma unroll
        for (int i = 0; i < 8; ++i) { const int k = d == 0 ? k0 + i : 255 - (k0 + i); er[i] = E[(rowbase + k) * 256 + colr]; ei[i] = E[(rowbase + k) * 256 + coli]; }
#pragma unroll
        for (int i = 0; i < 8; ++i) { const int k = d == 0 ? k0 + i : 255 - (k0 + i);
            bf16* o = UA + (rowbase + k) * UAW + 512; o[colr] = f2bf(hr); o[coli] = f2bf(hi);
            const float nr = lr * hr - li * hi + er[i], ni = lr * hi + li * hr + ei[i]; hr = nr; hi = ni; }
    }
}


__device__ __forceinline__ s16x4 vtr(LAS const unsigned char* p) { return __builtin_bit_cast(s16x4, __builtin_amdgcn_ds_read_tr16_b64_v4i16((LAS s16x4*)p)); }
__device__ __forceinline__ void f_attn(Frame& F) {
    LAS unsigned char* L = (LAS unsigned char*)F.lds;
    constexpr int RSL = 5120, NSL = 15, KOFF = 0, VOFF = NSL * RSL, ROFF = 2 * NSL * RSL;
    const bf16* Q = (const bf16*)(F.ws + WS_Q); const bf16* Kb = (const bf16*)(F.ws + WS_K); const bf16* Vb = (const bf16*)(F.ws + WS_V);
    bf16* MIX = (bf16*)(F.ws + WS_MIX); const float* rpb = F.in[I_RPB];
    LAS float* rpbL = (LAS float*)(L + ROFF);
    const int w = F.wave, lane = F.lane, g = lane >> 4, li = lane & 15, ro = w >> 1, wl = (w & 1) * 8;
    const unsigned pcol = (unsigned)(lane >> 3);
    const unsigned ksrc = pcol * (AW * 2) + ((unsigned)((lane & 7) ^ (lane >> 3)) << 4);
    const unsigned vsrc = pcol * (AW * 2) + ((unsigned)(2 * (((lane & 7) >> 1) ^ ((lane >> 4) & 3)) + (lane & 1)) << 4);
    const int kb0 = (wl + li) * 128 + (((0 + g) ^ (li & 7)) << 4), kb1 = (wl + li) * 128 + (((4 + g) ^ (li & 7)) << 4);
    const int q4 = li >> 2, p4 = li & 3, sw = (2 * g + (q4 >> 1)) & 3;
    const int vb = (wl + 4 * g + q4) * 128 + p4 * 8;
    int vo[4];
#pragma unroll
    for (int dt = 0; dt < 4; ++dt) vo[dt] = vb + ((dt ^ sw) << 5);
    const int NU = NBATCH * NH * 2 * (ROWS / 4);
    const int per = (NU + F.G - 1) / F.G;
    const int ub = F.bid * per, u1 = (F.bid + 1) * per < NU ? (F.bid + 1) * per : NU;
#define ATT_RS(r_) ((r_) - 4 < 0 ? 0 : ((r_) - 4 > ROWS - 8 ? ROWS - 8 : (r_) - 4))
#define ATT_STAGE_ROWS(row_lo, nrows) do { const int np_ = 10 * (nrows); for (int pi_ = w; pi_ < np_; pi_ += NWAVES) { const int ri_ = pi_ / 5, pc_ = pi_ - ri_ * 5; const bool isv_ = ri_ >= (nrows); const int row_ = (row_lo) + (isv_ ? ri_ - (nrows) : ri_); \
        __builtin_amdgcn_global_load_lds((const unsigned*)((isv_ ? vg : kg) + (size_t)row_ * (GW * AW * 2) + (size_t)pc_ * 8 * (AW * 2)), (LAS unsigned*)(L + (isv_ ? VOFF : KOFF) + (row_ % NSL) * RSL + pc_ * 1024), 16, 0, 0); } } while (0)
    pg8::bf16x8 qf[2], qn[2];
    qn[0] = qn[1] = (pg8::bf16x8){0, 0, 0, 0, 0, 0, 0, 0};
    int boff[2][4]; int c = 0;
    for (int u = ub; u < u1; ++u) {
        const int bhh = u >> 5, rg = u & 31, ch = bhh & 1, h = (bhh >> 1) & 7, b = bhh >> 4, r0 = rg * 4;
        const bool full = (u == ub) || (rg == 0);
        const bool nsame = (u + 1 < u1) && (((u + 1) & 31) != 0);
        const int cw0 = ch ? 24 : 0;
        const char* kg = (const char*)Kb + ((size_t)(b * SEQ + cw0) * AW + h * HD) * 2 + ksrc;
        const char* vg = (const char*)Vb + ((size_t)(b * SEQ + cw0) * AW + h * HD) * 2 + vsrc;
        const int rlo = ATT_RS(r0), rhi = ATT_RS(r0 + 3) + 7;
        const int r = r0 + ro, rsr = ATT_RS(r);
        if (full) {
            const int qt = 2 * ch + (w & 1), wbg = qt == 0 ? 0 : (qt == 1 ? 8 : (qt == 2 ? 24 : 32));
            c = 16 * qt + li; int cs = c - 8; cs = cs < 0 ? 0 : (cs > GW - 16 ? GW - 16 : cs);
#pragma unroll
            for (int hh = 0; hh < 2; ++hh)
#pragma unroll
                for (int e = 0; e < 4; ++e) { const int kc = wbg + 16 * hh + 4 * g + e; boff[hh][e] = (kc >= cs && kc < cs + 16) ? (kc - c + 15) * 4 : 15 * 31 * 4; }
            __syncthreads();
            ATT_STAGE_ROWS(rlo, rhi - rlo + 1);
            if (F.tid < 15 * 31) { rpbL[F.tid] = rpb[h * 15 * 31 + F.tid] * 1.4426950408889634f; rpbL[15 * 31 + F.tid] = -1e30f; }
            const size_t tq0 = (size_t)b * SEQ + (size_t)r * GW + c;
            qf[0] = *(const pg8::bf16x8*)(Q + tq0 * AW + h * HD + 8 * g); qf[1] = *(const pg8::bf16x8*)(Q + tq0 * AW + h * HD + 32 + 8 * g);
        } else { qf[0] = qn[0]; qf[1] = qn[1]; }
        const size_t tq = (size_t)b * SEQ + (size_t)r * GW + c;
        asm volatile("s_waitcnt vmcnt(0)" ::: "memory");
        __syncthreads();
        if (nsame) { const int nhi = ATT_RS(r0 + 7) + 7;
            if (nhi > rhi) ATT_STAGE_ROWS(rhi + 1, nhi - rhi);
            const size_t tn = tq + 4 * GW;
            qn[0] = *(const pg8::bf16x8*)(Q + tn * AW + h * HD + 8 * g); qn[1] = *(const pg8::bf16x8*)(Q + tn * AW + h * HD + 32 + 8 * g); }
        int sl0 = rsr % NSL;
        f32x4 sacc[8][2];
        float mx = -1e30f;
        int baddr[2][4];
#pragma unroll
        for (int hh = 0; hh < 2; ++hh)
#pragma unroll
            for (int e = 0; e < 4; ++e) baddr[hh][e] = ROFF + boff[hh][e] + (rsr - r + 7) * 124;
#pragma unroll
        for (int i = 0; i < 8; ++i) {
            const int slot = sl0 + i >= NSL ? sl0 + i - NSL : sl0 + i;
#pragma unroll
            for (int hh = 0; hh < 2; ++hh) {
                const pg8::bf16x8 k0 = *(const LAS pg8::bf16x8*)(L + KOFF + slot * RSL + hh * 2048 + kb0), k1 = *(const LAS pg8::bf16x8*)(L + KOFF + slot * RSL + hh * 2048 + kb1);
                f32x4 a = (f32x4){0.f, 0.f, 0.f, 0.f};
                a = __builtin_amdgcn_mfma_f32_16x16x32_bf16(k0, qf[0], a, 0, 0, 0);
                a = __builtin_amdgcn_mfma_f32_16x16x32_bf16(k1, qf[1], a, 0, 0, 0);
#pragma unroll
                for (int e = 0; e < 4; ++e) { a[e] = a[e] * 1.4426950408889634f + *(const LAS float*)(L + baddr[hh][e] + i * 124); mx = fmaxf(mx, a[e]); }
                sacc[i][hh] = a;
            }
        }
        mx = xmax32(xmax16(mx));
        float lsum = 0.f;
#pragma unroll
        for (int i = 0; i < 8; ++i)
#pragma unroll
            for (int hh = 0; hh < 2; ++hh)
#pragma unroll
                for (int e = 0; e < 4; ++e) { const float pv = __builtin_amdgcn_exp2f(sacc[i][hh][e] - mx); sacc[i][hh][e] = pv; lsum += pv; }
        lsum = xadd32(xadd16(lsum));
        f32x4 oacc[4];
#pragma unroll
        for (int dt = 0; dt < 4; ++dt) oacc[dt] = (f32x4){0.f, 0.f, 0.f, 0.f};
#pragma unroll
        for (int i = 0; i < 8; ++i) {
            const int slot = sl0 + i >= NSL ? sl0 + i - NSL : sl0 + i;
            const u32x4 pw = pack8(sacc[i][0], sacc[i][1]);
            const pg8::bf16x8 pf = __builtin_bit_cast(pg8::bf16x8, pw);
#pragma unroll
            for (int dt = 0; dt < 4; ++dt) {
                const s16x4 v0 = vtr(L + VOFF + slot * RSL + vo[dt]), v1 = vtr(L + VOFF + slot * RSL + 2048 + vo[dt]);
                const pg8::bf16x8 vf = (pg8::bf16x8){v0[0], v0[1], v0[2], v0[3], v1[0], v1[1], v1[2], v1[3]};
                oacc[dt] = __builtin_amdgcn_mfma_f32_16x16x32_bf16(vf, pf, oacc[dt], 0, 0, 0);
            }
        }
        const float inv = 1.0f / lsum;
#pragma unroll
        for (int dt = 0; dt < 4; ++dt) { u32x2 o; o.x = pg8::cvt_pk_bf16(oacc[dt][0] * inv, oacc[dt][1] * inv); o.y = pg8::cvt_pk_bf16(oacc[dt][2] * inv, oacc[dt][3] * inv);
            *(u32x2*)(MIX + tq * D + h * HD + 16 * dt + 4 * g) = o; }
    }
#undef ATT_STAGE_ROWS
#undef ATT_RS
    asm volatile("s_waitcnt vmcnt(0)" ::: "memory");
    __syncthreads();
}

__device__ __forceinline__ void f_ln1_router(Frame& F) {
    LAS unsigned char* L = (LAS unsigned char*)F.lds;
    constexpr int WOFF = 0, GBOFF = 72 * 2048, HOFF = GBOFF + 8192;
    const bf16* Z1 = (const bf16*)(F.ws + WS_Z1); fp8* H1F = (fp8*)(F.ws + WS_H1F); const bf16* WRT = (const bf16*)(F.ws + WS_WR_T);
    int* tokE = (int*)(F.ws + WS_TOKE); int* tokPos = (int*)(F.ws + WS_TOKPOS); float* tokW = (float*)(F.ws + WS_TOKW); int* elist = (int*)(F.ws + WS_ELIST);
    unsigned* counts = F.ctl + CW_CNT;
    LAS float* GB = (LAS float*)(L + GBOFF);
    LAS int* hist = (LAS int*)(L + HOFF); LAS int* base = hist + 64; LAS int* lE = base + 64; LAS int* lR = lE + 512; LAS float* lW = (LAS float*)(lR + 512);
    const int lane = F.lane, tk = lane & 15, g = lane >> 4;
    __syncthreads();
    for (int i = F.tid; i < 72 * 128; i += NTHR) { const int n = i >> 7, ch = i & 127; *(LAS u32x4*)(L + WOFF + n * 2048 + ((ch ^ (n & 15)) << 4)) = *(const u32x4*)(WRT + (size_t)n * D + ch * 8); }
    for (int i = F.tid; i < 2048; i += NTHR) GB[i] = i < 1024 ? F.in[I_LN1G][i] : F.in[I_LN1B][i - 1024];
    __syncthreads();
    int brow[5];
#pragma unroll
    for (int t = 0; t < 5; ++t) brow[t] = t < 4 ? 16 * t + tk : 64 + (tk & 7);
    const float be0 = F.in[I_BRE2][tk], be1 = F.in[I_BRE2][16 + tk], be2 = F.in[I_BRE2][32 + tk], be3 = F.in[I_BRE2][48 + tk], bg = F.in[I_BRG][tk & 7];
    for (int chunk = F.bid; chunk < T / 256; chunk += F.G) {
        if (F.tid < 64) hist[F.tid] = 0;
        __syncthreads();
#pragma unroll 1
        for (int grp = 0; grp < 2; ++grp) {
            const int tl0 = F.wave * 32 + grp * 16, t0 = chunk * 256 + tl0;
            const bf16* zp = Z1 + (size_t)(t0 + tk) * D + 8 * g;
            float s1 = 0.f, s2 = 0.f;
            { const f32x2_t* sp = (const f32x2_t*)(F.ws + WS_STATS) + (size_t)(4 * g) * T + (t0 + tk);
#pragma unroll
              for (int j = 0; j < 4; ++j) { const f32x2_t pj = sp[(size_t)j * T]; s1 += pj[0]; s2 += pj[1]; } }
            s1 = xadd32(xadd16(s1)); s2 = xadd32(xadd16(s2));
            const float mean = s1 * (1.0f / D), var = s2 * (1.0f / D) - mean * mean, rstd = rsqrtf(var + LN_EPS);
            if (g == 0) { f32x2_t mr; mr[0] = mean; mr[1] = rstd; ((f32x2_t*)(F.ws + WS_MR))[t0 + tk] = mr; }
            f32x4 acc[5];
#pragma unroll
            for (int t = 0; t < 5; ++t) acc[t] = (f32x4){0.f, 0.f, 0.f, 0.f};
            fp8* hp8 = H1F + (size_t)(t0 + tk) * D + 8 * g;
#define RT_LOAD(dst, blk) do { _Pragma("unroll") for (int i_ = 0; i_ < 4; ++i_) dst[i_] = *(const u32x4*)(zp + 32 * ((blk) * 4 + i_)); } while (0)
#define RT_PROC(src, blk) do { _Pragma("unroll") for (int i_ = 0; i_ < 4; ++i_) { const int sI = (blk) * 4 + i_; const u32x4 f = src[i_]; \
                const int k = 32 * sI + 8 * g; \
                const f32x4 g0 = *(const LAS f32x4*)(GB + k), g1 = *(const LAS f32x4*)(GB + k + 4), b0 = *(const LAS f32x4*)(GB + 1024 + k), b1 = *(const LAS f32x4*)(GB + 1024 + k + 4); \
                f32x4 v0, v1; \
                v0[0] = (__uint_as_float(f[0] << 16) - mean) * rstd * g0[0] + b0[0]; v0[1] = (__uint_as_float(f[0] & 0xffff0000u) - mean) * rstd * g0[1] + b0[1]; \
                v0[2] = (__uint_as_float(f[1] << 16) - mean) * rstd * g0[2] + b0[2]; v0[3] = (__uint_as_float(f[1] & 0xffff0000u) - mean) * rstd * g0[3] + b0[3]; \
                v1[0] = (__uint_as_float(f[2] << 16) - mean) * rstd * g1[0] + b1[0]; v1[1] = (__uint_as_float(f[2] & 0xffff0000u) - mean) * rstd * g1[1] + b1[1]; \
                v1[2] = (__uint_as_float(f[3] << 16) - mean) * rstd * g1[2] + b1[2]; v1[3] = (__uint_as_float(f[3] & 0xffff0000u) - mean) * rstd * g1[3] + b1[3]; \
                const u32x4 hw = pack8(v0, v1); \
                { u32x2 w8; w8.x = pk4_fp8(v0[0], v0[1], v0[2], v0[3]); w8.y = pk4_fp8(v1[0], v1[1], v1[2], v1[3]); *(u32x2*)(hp8 + 32 * sI) = w8; } \
                const pg8::bf16x8 af = __builtin_bit_cast(pg8::bf16x8, hw); \
                const int ch = 4 * sI + g; \
                _Pragma("unroll") for (int t = 0; t < 5; ++t) { const pg8::bf16x8 bfr = *(const LAS pg8::bf16x8*)(L + WOFF + brow[t] * 2048 + ((ch ^ (brow[t] & 15)) << 4)); \
                    acc[t] = __builtin_amdgcn_mfma_f32_16x16x32_bf16(af, bfr, acc[t], 0, 0, 0); } } } while (0)
            { u32x4 fa[4], fb[4];
              RT_LOAD(fa, 0);
#pragma unroll 1
              for (int blk = 0; blk < 8; blk += 2) {
                  RT_LOAD(fb, blk + 1);
                  RT_PROC(fa, blk);
                  if (blk + 2 < 8) RT_LOAD(fa, blk + 2);
                  RT_PROC(fb, blk + 1);
              } }
#undef RT_LOAD
#undef RT_PROC
#pragma unroll
            for (int r = 0; r < 4; ++r) {
                float gv = acc[4][r] + bg; int gi = tk & 7;
                const float gown = gv;
#pragma unroll
                for (int m = 1; m < 8; m <<= 1) { const float ov = __shfl_xor(gv, m); const int oi = __shfl_xor(gi, m); const bool take = ov > gv || (ov == gv && oi < gi); gv = take ? ov : gv; gi = take ? oi : gi; }
                float ge = __expf(gown - gv);
#pragma unroll
                for (int m = 1; m < 8; m <<= 1) ge += __shfl_xor(ge, m);
                const float gval = 1.0f / ge;
                const int tsel = gi >> 1;
                float ev = tsel == 0 ? acc[0][r] + be0 : (tsel == 1 ? acc[1][r] + be1 : (tsel == 2 ? acc[2][r] + be2 : acc[3][r] + be3));
                if ((tk >> 3) != (gi & 1)) ev = -3e38f;
                float v1 = ev; int i1 = tk & 7;
#pragma unroll
                for (int m = 1; m < 16; m <<= 1) { const float ov = __shfl_xor(v1, m); const int oi = __shfl_xor(i1, m); const bool take = ov > v1 || (ov == v1 && oi < i1); v1 = take ? ov : v1; i1 = take ? oi : i1; }
                float ev2 = ((tk & 7) == i1) ? -3e38f : ev; float v2 = ev2; int i2 = tk & 7;
#pragma unroll
                for (int m = 1; m < 16; m <<= 1) { const float ov = __shfl_xor(v2, m); const int oi = __shfl_xor(i2, m); const bool take = ov > v2 || (ov == v2 && oi < i2); v2 = take ? ov : v2; i2 = take ? oi : i2; }
                if (tk == 0) {
                    const float ex = __expf(v2 - v1), w0 = gval / (1.0f + ex), w1 = gval * ex / (1.0f + ex);
                    const int tl = tl0 + 4 * g + r, E0 = gi * EPG + i1, E1 = gi * EPG + i2;
                    lE[2 * tl] = E0; lE[2 * tl + 1] = E1; lW[2 * tl] = w0; lW[2 * tl + 1] = w1;
                    lR[2 * tl] = atomicAdd((int*)&hist[E0], 1); lR[2 * tl + 1] = atomicAdd((int*)&hist[E1], 1);
                }
            }
        }
        __syncthreads();
        if (F.tid < 64) base[F.tid] = (int)__hip_atomic_fetch_add(&counts[F.tid], (unsigned)hist[F.tid], __ATOMIC_RELAXED, __HIP_MEMORY_SCOPE_AGENT);
        __syncthreads();
        { const int a = F.tid, ga = chunk * 512 + a; const int e = lE[a], pos = base[e] + lR[a]; tokE[ga] = e; tokPos[ga] = pos; tokW[ga] = lW[a]; elist[(size_t)e * ECAP + pos] = ga >> 1; }
        __syncthreads();
    }
}

__device__ __forceinline__ void f_proj(Frame& F) {
    DenseSched S{(unsigned)WS_XB, (unsigned)WS_WIN_T, T / 256, INW / 256, F.G, F.bid, 256u * D * 2, 256u * D * 2, 1 << 30, 0};
    EpiProj E{(bf16*)(F.ws + WS_Q), (bf16*)(F.ws + WS_UA)};
    static_assert(WS_V - WS_K == WS_K - WS_Q, "Q|K|V spacing");
    pg8::gemm_phase<EpiProj, DenseSched, false, false, ENG_SP2>((LAS unsigned char*)F.lds, F.ws, D * 2, D * 2, D / 64, S, E);
}
__device__ __forceinline__ void f_glu(Frame& F) {
    DenseSched S{(unsigned)WS_G, (unsigned)WS_WGLU_T, T / 256, SW / 256, F.G, F.bid, 256u * SW * 2, 256u * SW * 2, 1 << 30, 0};
    EpiGlu E{(const bf16*)(F.ws + WS_G), (bf16*)(F.ws + WS_MIX), F.in[I_BGLU]};
    pg8::gemm_phase<EpiGlu, DenseSched, false, false, ENG_SP2>((LAS unsigned char*)F.lds, F.ws, SW * 2, SW * 2, SW / 64, S, E);
}
__device__ __forceinline__ void f_wout(Frame& F) {
    DenseSched S{(unsigned)WS_MIX, (unsigned)WS_WOUT_T, T / 256, D / 256, F.G, F.bid, 256u * D * 2, 256u * D * 2, 1 << 30, 0};
    EpiWout E{(bf16*)(F.ws + WS_Z1), (f32x2_t*)(F.ws + WS_STATS)};
    static_assert(WS_Z1 == WS_XB, "Z1 overlays XB");
    pg8::gemm_phase<EpiWout, DenseSched, false, false, ENG_SP2>((LAS unsigned char*)F.lds, F.ws, D * 2, D * 2, D / 64, S, E);
}
__device__ __forceinline__ void f_gateup(Frame& F) {
    int* pb = (int*)(F.lds + pg8::STAGE_BYTES);
    load_pbase(F, pb);
    MoeSched S{(unsigned)WS_H1F, (unsigned)WS_WGU_T, (const int*)(F.ws + WS_ELIST), pb, pb[64] / 256, 4, F.G, F.bid, 0u, 256u * D, 1024u * D, (unsigned)WS_ELIST};
    EpiGateUp E{(fp8*)(F.ws + WS_HID)};
    pg8::gemm_phase<EpiGateUp, MoeSched, true, true>((LAS unsigned char*)F.lds, F.ws, D, D, D / 128, S, E);
}
__device__ __forceinline__ void f_down(Frame& F) {
    int* pb = (int*)(F.lds + pg8::STAGE_BYTES);
    load_pbase(F, pb);
    MoeSched S{(unsigned)WS_HID, (unsigned)WS_WDN_T, nullptr, pb, pb[64] / 256, 4, F.G, F.bid, 256u * DE, 256u * DE, (unsigned)D * DE, 0u};
    EpiDown E{(fp8*)(F.ws + WS_O)};
    pg8::gemm_phase<EpiDown, MoeSched, false, true>((LAS unsigned char*)F.lds, F.ws, DE, DE, DE / 128, S, E);
}

__device__ __forceinline__ void mkframe(Frame& F, const Args& args, unsigned char* l) {
    F.lds = l; F.ws = args.ws; F.ctl = (unsigned*)(args.ws + WS_CTL);
    F.tid = threadIdx.x; F.lane = F.tid & 63; F.wave = __builtin_amdgcn_readfirstlane(F.tid >> 6); F.G = gridDim.x; F.bid = blockIdx.x;
    F.in = args.in; F.out = args.out;
}
constexpr int NPHASE = 11;
__global__ void __launch_bounds__(NTHR, 2) fwd(Args args) {
    extern __shared__ __attribute__((aligned(16))) unsigned char lds[];
    Frame F; mkframe(F, args, lds);
    volatile LAS unsigned* misc = (volatile LAS unsigned*)((LAS unsigned char*)lds + LDS_BYTES - 64);
    if (F.tid < 16) misc[F.tid] = 0u;
    __syncthreads();
    const int lo = args.ph_lo, hi = args.ph_hi;
    XcdBarrier bar; bar.bar = F.ctl + CW_BAR; bar.x = 0; bar.st = misc;
    if (hi - lo > 1) bar = xcd_barrier_post(F.ctl + CW_BAR, misc);
#define IN(k) (lo <= (k) && (k) < hi)
#define SEAM(k) do { if (IN(k) && IN((k) + 1)) xcd_barrier(bar); } while (0)
#define SEAMF(k) do { if (IN(k) && IN((k) + 1)) xcd_barrier_fill(bar, F); } while (0)
#define RUNP(k, body) do { if (IN(k)) { body; } } while (0)
    RUNP(0, { if (F.bid < SG * 4 || F.G < 256) p0_s5tables(F);
              p0_prologue(F); }); SEAMF(0);
    RUNP(1, f_proj(F)); SEAMF(1);
    RUNP(2, { f_attn(F); f_s5e(F); }); SEAMF(2);
    if (F.G < T / 256) { RUNP(3, f_s5scan(F)); SEAM(3); }
    if (F.G < T / 256) { RUNP(4, f_s5y(F)); SEAMF(4); }
    RUNP(5, f_glu(F)); SEAMF(5);
    RUNP(6, f_wout(F)); SEAMF(6);
    if (IN(7)) { f_ln1_router(F); moe_drain(F); }
    if (IN(7) && IN(9)) xcd_barrier(bar);
    RUNP(9, f_gateup(F)); SEAM(9);
    RUNP(10, f_down(F)); SEAM(10);
    RUNP(11, p_final(F));
#undef RUNP
#undef IN
#undef SEAM
#undef SEAMF
}

extern "C" void kernel_launch(void* const* d_in, const int* in_sizes, int n_in, void* d_out, int out_size, void* d_ws, size_t ws_size, hipStream_t stream) {
    static int grid = 0;
    if (grid == 0) {
        if (n_in != 25 || out_size != T * D || ws_size < WS_END) { fprintf(stderr, "kernel_launch: unexpected shapes n_in %d out %d ws %zu\n", n_in, out_size, ws_size); grid = -1; return; }
        int dev = 0, cus = 0;
        if (hipGetDevice(&dev) != hipSuccess || hipDeviceGetAttribute(&cus, hipDeviceAttributeMultiprocessorCount, dev) != hipSuccess) { grid = -1; return; }
        if (hipFuncSetAttribute((const void*)fwd, hipFuncAttributeMaxDynamicSharedMemorySize, LDS_BYTES) != hipSuccess) { fprintf(stderr, "kernel_launch: hipFuncSetAttribute failed\n"); grid = -1; return; }
        int per_cu = 0;
        if (hipOccupancyMaxActiveBlocksPerMultiprocessor(&per_cu, (const void*)fwd, NTHR, LDS_BYTES) != hipSuccess || per_cu < 1) fprintf(stderr, "kernel_launch: occupancy query says %d\n", per_cu);
        (void)hipGetLastError();
        grid = cus;
    }
    if (grid < 0) return;
    (void)hipMemsetAsync((char*)d_ws + WS_CTL, 0, CTL_ZERO_BYTES, stream);
    Args a{};
    for (int i = 0; i < 25; ++i) a.in[i] = (const float*)d_in[i];
    a.out = (float*)d_out; a.ws = (unsigned char*)d_ws;
#define LAUNCH_FAST(lo_, hi_) do { a.ph_lo = lo_; a.ph_hi = hi_; a.li = lo_; a.pad = 0; hipLaunchKernelGGL(fwd, dim3(grid), dim3(NTHR), LDS_BYTES, stream, a); } while (0)
#ifdef MK_PER_PHASE
    for (int p = 0; p < 12; ++p) LAUNCH_FAST(p, p + 1);
#else
    LAUNCH_FAST(0, 12);
#endif
}
```

```cpp
#include <hip/hip_runtime.h>
#include <cstdio>
#include <cstdint>

#define GAS __attribute__((address_space(1)))
#define LAS __attribute__((address_space(3)))
typedef unsigned short bf16;
typedef float f32x4 __attribute__((ext_vector_type(4)));
typedef unsigned u32x4 __attribute__((ext_vector_type(4)));
typedef unsigned u32x2 __attribute__((ext_vector_type(2)));
typedef short s16x4 __attribute__((ext_vector_type(4)));
typedef int v8i __attribute__((ext_vector_type(8)));
typedef float f32x2_t __attribute__((ext_vector_type(2)));
typedef unsigned char fp8;

constexpr int D = 1024, NBATCH = 8, SEQ = 8192, T = NBATCH * SEQ, GW = 64, ROWS = SEQ / GW, NH = 8, HD = 64, AW = 512, SW = 512;
constexpr int SG = 32, SC = 16, SP = 64, INW = 2048, NEG = 8, EPG = 8, NE = 64, DE = 512;
constexpr int TB = 32;
constexpr int NBLK = T / TB;
constexpr int UAW = TB * SC + 4 * SP;
constexpr float LN_EPS = 1e-5f;
constexpr float ALPHA = 1.189207115002721f;
constexpr int MAXTILES = (2 * T + NE * 255) / 256 + 1;
constexpr int NWAVES = 8, NTHR = 512;
constexpr int ECAP = 2 * T;

constexpr size_t MiB = 1u << 20;
constexpr size_t WS_CTL = 0, CTL_ZERO_BYTES = 32 * 1024;
constexpr size_t WS_TOKE = 1 * MiB, WS_TOKPOS = WS_TOKE + 512 * 1024, WS_TOKW = 2 * MiB;
constexpr size_t WS_S5TAB = 5 * MiB;
constexpr size_t WS_WIN_T = 8 * MiB, WS_WGLU_T = 12 * MiB, WS_WR_T = 12 * MiB + 512 * 1024, WS_WOUT_T = 13 * MiB;
constexpr size_t WS_KY = 16 * MiB, WS_WE = 40 * MiB, WS_WGU_T = 48 * MiB, WS_WDN_T = 176 * MiB;
constexpr size_t WS_XB = 240 * MiB, WS_Z1 = 240 * MiB;
constexpr size_t WS_Q = 368 * MiB, WS_K = 432 * MiB, WS_V = 496 * MiB, WS_UA = 560 * MiB, WS_E = 656 * MiB, WS_G = 720 * MiB, WS_MIX = 784 * MiB, WS_H1 = 784 * MiB;
constexpr size_t WS_HID = 784 * MiB  , WS_O = 384 * MiB, WS_H1F = 912 * MiB  , WS_ELIST = 976 * MiB  , WS_STATS = 1008 * MiB  , WS_MR = 1016 * MiB  , WS_END = 1017 * MiB;
static_assert((4096 + 3456) * 4 <= 32 * 1024, "control words inside the memset region");
constexpr int CW_TMO = 0, CW_XQ = 512  , CW_MQ = 576  , CW_CNT = 1024  , CW_BAR = 4096;

constexpr int LDS_BYTES = 163840;

__device__ __forceinline__ float bf2f(bf16 b) { return __uint_as_float(((unsigned)b) << 16); }
__device__ __forceinline__ bf16 f2bf(float f) { unsigned u = __float_as_uint(f); return (bf16)((u + 0x7fffu + ((u >> 16) & 1u)) >> 16); }
__device__ __forceinline__ unsigned pk2(float lo, float hi) { return (unsigned)f2bf(lo) | ((unsigned)f2bf(hi) << 16); }
__device__ __forceinline__ unsigned pk4_fp8(float a, float b, float c, float d) { int w = 0; w = __builtin_amdgcn_cvt_pk_fp8_f32(a, b, w, false); w = __builtin_amdgcn_cvt_pk_fp8_f32(c, d, w, true); return (unsigned)w; }
__device__ __forceinline__ float xadd16(float x) { const unsigned b = __float_as_uint(x); const auto r = __builtin_amdgcn_permlane16_swap(b, b, false, false); return __uint_as_float(r[0]) + __uint_as_float(r[1]); }
__device__ __forceinline__ float xadd32(float x) { const unsigned b = __float_as_uint(x); const auto r = __builtin_amdgcn_permlane32_swap(b, b, false, false); return __uint_as_float(r[0]) + __uint_as_float(r[1]); }
__device__ __forceinline__ float xmax16(float x) { const unsigned b = __float_as_uint(x); const auto r = __builtin_amdgcn_permlane16_swap(b, b, false, false); return fmaxf(__uint_as_float(r[0]), __uint_as_float(r[1])); }
__device__ __forceinline__ float xmax32(float x) { const unsigned b = __float_as_uint(x); const auto r = __builtin_amdgcn_permlane32_swap(b, b, false, false); return fmaxf(__uint_as_float(r[0]), __uint_as_float(r[1])); }
__device__ __forceinline__ float wave_sum(float v) {
#pragma unroll
    for (int o = 1; o < 64; o <<= 1) v += __shfl_xor(v, o);
    return v;
}
__device__ __forceinline__ float sigmoidf_(float x) { return __builtin_amdgcn_rcpf(1.0f + __builtin_amdgcn_exp2f(-1.4426950408889634f * x)); }
__device__ __forceinline__ float gelu_tanh(float x) { const float z = 0.7978845608028654f * (x + 0.044715f * x * x * x); return x * sigmoidf_(2.0f * z); }

#define XB_TMO      128
#define XB_XCNT(j)  (256  + 64 * (j))
#define XB_XSUB(j)  (1280 + 64 * (j))
#define XB_XGEN(j)  (2304 + 64 * (j))
#define XB_TOP      3328
#define XB_TOPGEN   3392
#define XCD_BAR_WORDS 3456
#define XB_SPIN_CAP (1u << 18)
__device__ __forceinline__ unsigned xb_ld(unsigned* p)              { return __hip_atomic_load(p, __ATOMIC_RELAXED, __HIP_MEMORY_SCOPE_AGENT); }
__device__ __forceinline__ unsigned xb_add(unsigned* p, unsigned v) { return __hip_atomic_fetch_add(p, v, __ATOMIC_RELAXED, __HIP_MEMORY_SCOPE_AGENT); }
__device__ __forceinline__ unsigned xb_xcc_id() { return (unsigned)__builtin_amdgcn_s_getreg((3 << 11) | 20) & 0xFu; }
#define XB_SPIN(cond, bar) do { unsigned _sp = 0; while (cond) { __builtin_amdgcn_s_sleep(1); \
    if ((++_sp & 255u) == 0u) { if (xb_ld(&(bar)[XB_TMO])) break; if (_sp > XB_SPIN_CAP) { atomicAdd(&(bar)[XB_TMO], 1u); break; } } } } while (0)
struct XcdBarrier { unsigned* bar; unsigned x; volatile LAS unsigned* st; };
__device__ __forceinline__ XcdBarrier xcd_barrier_post(unsigned* bar, volatile LAS unsigned* st) {
    XcdBarrier b; b.bar = bar; b.x = xb_xcc_id(); b.st = st;
    if (threadIdx.x == 0) (void)xb_add(&bar[XB_XCNT(b.x)], 1u);
    return b;
}
__device__ __forceinline__ void xcd_barrier_complete(unsigned* bar, unsigned x, unsigned& nloc, unsigned& nx) {
    const unsigned G = gridDim.x * gridDim.y * gridDim.z;
    unsigned sum, cnt, mine, sp = 0u;
    for (;;) {
        sum = 0u; cnt = 0u; mine = 0u;
#pragma unroll
        for (unsigned j = 0; j < 16; ++j) { const unsigned c = xb_ld(&bar[XB_XCNT(j)]); sum += c; cnt += (c > 0u) ? 1u : 0u; mine = (j == x) ? c : mine; }
        if (sum == G) break;
        __builtin_amdgcn_s_sleep(1);
        if ((++sp & 255u) == 0u) { if (xb_ld(&bar[XB_TMO])) break; if (sp > XB_SPIN_CAP) { atomicAdd(&bar[XB_TMO], 1u); break; } }
    }
    nloc = mine > 0u ? mine : 1u; nx = cnt > 0u ? cnt : 1u;
}
__device__ __forceinline__ void xcd_barrier(const XcdBarrier& b) {
    asm volatile("s_waitcnt vmcnt(0)" ::: "memory");
    __syncthreads();
    if (threadIdx.x == 0) {
        unsigned* bar = b.bar;
        __builtin_amdgcn_s_waitcnt(0);
        unsigned nloc = b.st[0], nx = b.st[1];
        if (nloc == 0u) { xcd_barrier_complete(bar, b.x, nloc, nx); b.st[0] = nloc; b.st[1] = nx; }
        const unsigned old = xb_add(&bar[XB_XSUB(b.x)], 1u);
        const unsigned gen = old / nloc;
        if (old + 1u == (gen + 1u) * nloc) {
            __builtin_amdgcn_fence(__ATOMIC_RELEASE, "agent");
            asm volatile("s_waitcnt vmcnt(0)" ::: "memory");
            const unsigned og = xb_add(&bar[XB_TOP], 1u);
            const unsigned tg = og / nx;
            if (og + 1u == (tg + 1u) * nx) xb_add(&bar[XB_TOPGEN], 1u);
            else XB_SPIN(xb_ld(&bar[XB_TOPGEN]) == tg, bar);
            __builtin_amdgcn_fence(__ATOMIC_ACQUIRE, "agent");
            xb_add(&bar[XB_XGEN(b.x)], 1u);
            asm volatile("s_waitcnt vmcnt(0)" ::: "memory");
        } else {
            XB_SPIN(xb_ld(&bar[XB_XGEN(b.x)]) == gen, bar);
            __builtin_amdgcn_fence(__ATOMIC_ACQUIRE, "agent");
            asm volatile("s_waitcnt vmcnt(0)" ::: "memory");
        }
    }
    __syncthreads();
}

struct Args { const float* in[25]; float* out; unsigned char* ws; int ph_lo, ph_hi, li, pad; };
struct Frame {
    unsigned char* lds;
    unsigned char* ws; unsigned* ctl;
    int tid, lane, wave, G, bid;
    const float* const* in; float* out;
};
enum { I_X = 0, I_WIN, I_RPB, I_ARE, I_AIM, I_LDT, I_BRE, I_BIM, I_CRE, I_CIM, I_SD, I_WGLU, I_BGLU, I_WOUT, I_LN1G, I_LN1B, I_WRG, I_BRG, I_WRE, I_BRE2, I_WGATE, I_WUP, I_WDOWN, I_LN2G, I_LN2B };

__device__ __forceinline__ void load_pbase(Frame& F, int* pb) {
    if (F.tid == 0) { int acc = 0; for (int e = 0; e < NE; ++e) { pb[e] = acc; const int c = (int)__hip_atomic_load(&F.ctl[CW_CNT + e], __ATOMIC_RELAXED, __HIP_MEMORY_SCOPE_AGENT); acc += (c + 255) / 256 * 256; pb[66 + e] = c; } pb[64] = acc; }
    __syncthreads();
    for (int t = F.tid; t < MAXTILES; t += NTHR) { int e = 0; for (int j = 1; j < NE; ++j) e = (pb[j] <= t * 256) ? j : e; pb[132 + t] = e; }
    __syncthreads();
}
__device__ __forceinline__ float fp8_to_f32(unsigned w, int sel) { return sel == 0 ? __builtin_amdgcn_cvt_f32_fp8((int)w, 0) : (sel == 1 ? __builtin_amdgcn_cvt_f32_fp8((int)w, 1) : (sel == 2 ? __builtin_amdgcn_cvt_f32_fp8((int)w, 2) : __builtin_amdgcn_cvt_f32_fp8((int)w, 3))); }
__device__ __forceinline__ void p_final(Frame& F) {
    int* pb = (int*)F.lds;
    load_pbase(F, pb);
    const int* tokE = (const int*)(F.ws + WS_TOKE); const int* tokPos = (const int*)(F.ws + WS_TOKPOS);
    const bf16* Z1 = (const bf16*)(F.ws + WS_Z1); const fp8* O = (const fp8*)(F.ws + WS_O); const f32x2_t* MR = (const f32x2_t*)(F.ws + WS_MR);
    const float* tokW = (const float*)(F.ws + WS_TOKW);
    const float* g1 = F.in[I_LN1G]; const float* b1 = F.in[I_LN1B]; const float* g2 = F.in[I_LN2G]; const float* b2 = F.in[I_LN2B];
    const int lane = F.lane;
    constexpr int NT4 = 4;
    for (int tb = (F.bid * NWAVES + F.wave) * NT4; tb < T; tb += F.G * NWAVES * NT4) {
        u32x2 h[NT4][4]; unsigned a[NT4][4], b[NT4][4]; float w0[NT4], w1[NT4], mean1[NT4], rstd1[NT4];
#pragma unroll
        for (int q = 0; q < NT4; ++q) { const int t = tb + q; const int s0 = pb[tokE[2 * t]] + tokPos[2 * t], s1 = pb[tokE[2 * t + 1]] + tokPos[2 * t + 1]; w0[q] = tokW[2 * t] * 0.125f; w1[q] = tokW[2 * t + 1] * 0.125f;
            { const f32x2_t mr = MR[t]; mean1[q] = mr[0]; rstd1[q] = mr[1]; }
#pragma unroll
            for (int j = 0; j < 4; ++j) { const int c = 256 * j + lane * 4; h[q][j] = *(const u32x2*)(Z1 + (size_t)t * D + c); a[q][j] = *(const unsigned*)(O + (size_t)s0 * D + c); b[q][j] = *(const unsigned*)(O + (size_t)s1 * D + c); } }
#pragma unroll
        for (int q = 0; q < NT4; ++q) { const int t = tb + q;
            float v[16];
#pragma unroll
            for (int j = 0; j < 4; ++j) {
                const int c = 256 * j + lane * 4; const f32x4 gg = *(const f32x4*)(g1 + c), bb = *(const f32x4*)(b1 + c);
                const float z0 = __uint_as_float(h[q][j].x << 16), z1 = __uint_as_float(h[q][j].x & 0xffff0000u), z2 = __uint_as_float(h[q][j].y << 16), z3 = __uint_as_float(h[q][j].y & 0xffff0000u);
                v[4 * j + 0] = ALPHA * ((z0 - mean1[q]) * rstd1[q] * gg[0] + bb[0]) + (w0[q] * fp8_to_f32(a[q][j], 0) + w1[q] * fp8_to_f32(b[q][j], 0));
                v[4 * j + 1] = ALPHA * ((z1 - mean1[q]) * rstd1[q] * gg[1] + bb[1]) + (w0[q] * fp8_to_f32(a[q][j], 1) + w1[q] * fp8_to_f32(b[q][j], 1));
                v[4 * j + 2] = ALPHA * ((z2 - mean1[q]) * rstd1[q] * gg[2] + bb[2]) + (w0[q] * fp8_to_f32(a[q][j], 2) + w1[q] * fp8_to_f32(b[q][j], 2));
                v[4 * j + 3] = ALPHA * ((z3 - mean1[q]) * rstd1[q] * gg[3] + bb[3]) + (w0[q] * fp8_to_f32(a[q][j], 3) + w1[q] * fp8_to_f32(b[q][j], 3));
            }
            float s = 0.f;
#pragma unroll
            for (int j = 0; j < 16; ++j) s += v[j];
            const float mean = wave_sum(s) * (1.0f / D);
            float qv = 0.f;
#pragma unroll
            for (int j = 0; j < 16; ++j) { v[j] -= mean; qv += v[j] * v[j]; }
            const float rstd = rsqrtf(wave_sum(qv) * (1.0f / D) + LN_EPS);
#pragma unroll
            for (int j = 0; j < 4; ++j) {
                const int c = 256 * j + lane * 4; const f32x4 gg = *(const f32x4*)(g2 + c), bb = *(const f32x4*)(b2 + c);
                f32x4 o;
#pragma unroll
                for (int e = 0; e < 4; ++e) o[e] = v[4 * j + e] * rstd * gg[e] + bb[e];
                *(f32x4*)(F.out + (size_t)t * D + c) = o;
            }
        }
    }
}

#ifndef ENG_SP2
#define ENG_SP2 true
#endif
namespace pg8 {
typedef short bf16x8 __attribute__((ext_vector_type(8)));
constexpr int BM = 256, BK = 64, HALF = 128, HTB = HALF * BK * 2, STAGE_BYTES = 8 * HTB, NXCD = 8, WGM = 8;
__host__ __device__ __forceinline__ int lds_byte(int r, int c) { const int st = (r >> 4) * 2 + (c >> 5), rr = r & 15, cc = c & 31, ob = rr * 64 + cc * 2; return st * 1024 + (ob ^ (((ob >> 9) & 1) << 5)); }
__host__ __device__ __forceinline__ void stage_rc(int b, int& R, int& C) { const int st = b / 1024, sb = b % 1024, swz = sb ^ (((sb >> 9) & 1) << 5); R = (st >> 1) * 16 + swz / 64; C = (st & 1) * 32 + (swz % 64) / 2; }
__host__ __device__ __forceinline__ int perm32(int rho) { const int n = rho >> 4, i = rho & 15; return 8 * (i >> 2) + 4 * n + (i & 3); }
__device__ __forceinline__ unsigned cvt_pk_bf16(float lo, float hi) { unsigned r; asm volatile("v_cvt_pk_bf16_f32 %0, %1, %2" : "=v"(r) : "v"(lo), "v"(hi)); return r; }

struct Unit { int pm, pn, aux; unsigned A, B; const int* rows; unsigned rows_off; int nvalid; };
typedef int i32x4 __attribute__((ext_vector_type(4)));
template <bool F8> struct Frag { bf16x8 kh[2]; };
template <> struct Frag<true> { v8i v; };
__device__ __forceinline__ void tile_of(int L, int nM, int nN, int& pm, int& pn) {
    const int nwg = nM * nN; int wgid = L;
    { const int q = nwg / NXCD, r = nwg % NXCD, xcd = wgid % NXCD, off = wgid / NXCD; wgid = (xcd < r ? xcd * (q + 1) : r * (q + 1) + (xcd - r) * q) + off; }
    const int nig = WGM * nN, gid = wgid / nig, fm = gid * WGM, gsz = (nM - fm) < WGM ? (nM - fm) : WGM;
    pm = fm + ((wgid % nig) % gsz); pn = (wgid % nig) / gsz;
}

template <class Epi, class Sched, bool GATHER, bool F8 = false, bool SP2 = true>
__device__ __forceinline__ void gemm_phase(LAS unsigned char* lds, const unsigned char* wsbase, const int lda, const int ldb, const int nt, const Sched& S, const Epi& E) {
    const __amdgpu_buffer_rsrc_t rsrc = __builtin_amdgcn_make_buffer_rsrc((void*)wsbase, 0, 0x7fffffff, 0x00020000);
    const int tid = threadIdx.x, wid = __builtin_amdgcn_readfirstlane(tid >> 6), lane = tid & 63, wr = wid >> 2, wc = wid & 3, fr = lane & 15, fq = lane >> 4;
    unsigned voffA[2], voffB[2];
#pragma unroll
    for (int i = 0; i < 2; ++i) { int R, C; stage_rc(tid * 16 + i * 8192, R, C); const int Rb = Epi::PERM ? ((R & ~31) + perm32(R & 31)) : R;
        voffA[i] = (unsigned)(R * lda + C * 2); voffB[i] = (unsigned)(Rb * ldb + C * 2); }
    const unsigned kstep = (unsigned)(BK * 2);
    const unsigned hstepA = (unsigned)(HALF * lda), hstepB = (unsigned)(HALF * ldb);
    const unsigned ldsw = (unsigned)wid * 1024u;
    const int aoff = F8 ? lds_byte(wr * 64 + fr, fq * 16) : lds_byte(wr * 64 + fr, fq * 8), boff = F8 ? lds_byte(wc * 32 + fr, fq * 16) : lds_byte(wc * 32 + fr, fq * 8);

    LAS unsigned char* const ldsA = lds + aoff; LAS unsigned char* const ldsB = lds + 4 * HTB + boff;
#define PG8_SA(b, h) (((b) * 2 + (h)) * HTB)
#define PG8_SB(b, h) ((4 + (b) * 2 + (h)) * HTB)
#define PG8_STAGE(bufoff, gbase, voff) do { _Pragma("unroll") for (int _i = 0; _i < 2; ++_i) \
        __builtin_amdgcn_raw_ptr_buffer_load_lds(rsrc, (LAS unsigned*)(lds + (bufoff) + ldsw + _i * 8192), 16, (int)(voff)[_i], (int)(gbase), 0, 0); } while (0)
#define PG8_STAGE_A(b, h, base, vg) do { if constexpr (GATHER) { PG8_STAGE(PG8_SA(b, h), base, (vg)[h]); } else { PG8_STAGE(PG8_SA(b, h), (base) + (h) * hstepA, voffA); } } while (0)
#define PG8_RD16(base, off) (*(const LAS i32x4*)((base) + (off)))
#define PG8_LDA(dst, b, h) do { _Pragma("unroll") for (int m = 0; m < 4; ++m) { if constexpr (F8) { const i32x4 lo_ = PG8_RD16(ldsA, PG8_SA(b, h) + m * 2048), hi_ = PG8_RD16(ldsA, PG8_SA(b, h) + m * 2048 + 16); dst[m].v = __builtin_shufflevector(lo_, hi_, 0, 1, 2, 3, 4, 5, 6, 7); } \
        else { _Pragma("unroll") for (int k = 0; k < 2; ++k) dst[m].kh[k] = *(const LAS bf16x8*)(ldsA + PG8_SA(b, h) + m * 2048 + k * 1024); } } } while (0)
#define PG8_LDB(dst, b, h) do { _Pragma("unroll") for (int n = 0; n < 2; ++n) { if constexpr (F8) { const i32x4 lo_ = PG8_RD16(ldsB, ((b) * 2 + (h)) * HTB + n * 2048), hi_ = PG8_RD16(ldsB, ((b) * 2 + (h)) * HTB + n * 2048 + 16); dst[n].v = __builtin_shufflevector(lo_, hi_, 0, 1, 2, 3, 4, 5, 6, 7); } \
        else { _Pragma("unroll") for (int k = 0; k < 2; ++k) dst[n].kh[k] = *(const LAS bf16x8*)(ldsB + ((b) * 2 + (h)) * HTB + n * 2048 + k * 1024); } } } while (0)
#define PG8_MMA(ai, bj, At, Bt) do { __builtin_amdgcn_s_setprio(1); \
        if constexpr (F8) { _Pragma("unroll") for (int m = 0; m < 4; ++m) _Pragma("unroll") for (int n = 0; n < 2; ++n) \
            acc[ai][bj][m][n] = __builtin_amdgcn_mfma_scale_f32_16x16x128_f8f6f4(Bt[n].v, At[m].v, acc[ai][bj][m][n], 0, 0, 0, Epi::SCALE_B, 0, Epi::SCALE_A); } \
        else { _Pragma("unroll") for (int m = 0; m < 4; ++m) _Pragma("unroll") for (int n = 0; n < 2; ++n) _Pragma("unroll") for (int k = 0; k < 2; ++k) \
            acc[ai][bj][m][n] = __builtin_amdgcn_mfma_f32_16x16x32_bf16(Bt[n].kh[k], At[m].kh[k], acc[ai][bj][m][n], 0, 0, 0); } \
        __builtin_amdgcn_s_setprio(0); } while (0)
#define PG8_WAIT_V(n) asm volatile("s_waitcnt vmcnt(" #n ")" ::: "memory")
#define PG8_WAIT_L(n) asm volatile("s_waitcnt lgkmcnt(" #n ")" ::: "memory")
#define PG8_BAR __builtin_amdgcn_s_barrier()
#define PG8_SCHED __builtin_amdgcn_sched_barrier(0)
    Unit cur, nxt; int ui = 0;
    if (!S.next(0, cur)) return;
    f32x4 acc[2][2][4][2];
#pragma unroll
    for (int a = 0; a < 2; ++a)
#pragma unroll
        for (int b = 0; b < 2; ++b)
#pragma unroll
            for (int m = 0; m < 4; ++m)
#pragma unroll
                for (int n = 0; n < 2; ++n) acc[a][b][m][n] = (f32x4){0.f, 0.f, 0.f, 0.f};
    Frag<F8> At[4], B0[2], B1[2];
    unsigned vgc[2][2];
#define PG8_GATHER_OFFS(U) do { int tz_ = threadIdx.x; asm volatile("" : "+v"(tz_)); _Pragma("unroll") for (int i_ = 0; i_ < 2; ++i_) { int R_, C_; stage_rc(tz_ * 16 + i_ * 8192, R_, C_); \
        _Pragma("unroll") for (int h_ = 0; h_ < 2; ++h_) { const int rr_ = h_ * HALF + R_; const int tok_ = rr_ < (U).nvalid ? (U).rows[rr_] : 0; vgc[h_][i_] = (unsigned)tok_ * (unsigned)lda + (unsigned)(C_ * 2); } } } while (0)
    if constexpr (GATHER) PG8_GATHER_OFFS(cur);
    LAS int* const idxL = (LAS int*)(lds + STAGE_BYTES + 4096);
#define PG8_GATHER_OFFS_LDS(U) do { int tz_ = threadIdx.x; asm volatile("" : "+v"(tz_)); _Pragma("unroll") for (int i_ = 0; i_ < 2; ++i_) { int R_, C_; stage_rc(tz_ * 16 + i_ * 8192, R_, C_); \
        _Pragma("unroll") for (int h_ = 0; h_ < 2; ++h_) { const int rr_ = h_ * HALF + R_; const int tok_ = rr_ < (U).nvalid ? idxL[rr_] : 0; vgc[h_][i_] = (unsigned)tok_ * (unsigned)lda + (unsigned)(C_ * 2); } } } while (0)
    unsigned cA = cur.A, cB = cur.B;
    if constexpr (SP2) {
        PG8_STAGE(PG8_SB(0, 0), cB, voffB); PG8_STAGE(PG8_SB(0, 1), cB + hstepB, voffB); PG8_STAGE_A(0, 0, cA, vgc); PG8_STAGE_A(0, 1, cA, vgc);
        if (wr == 1) PG8_BAR;
        PG8_WAIT_V(2); PG8_BAR;
        PG8_STAGE(PG8_SB(1, 0), cB + kstep, voffB); PG8_STAGE_A(1, 0, cA + kstep, vgc); PG8_STAGE(PG8_SB(1, 1), cB + hstepB + kstep, voffB);
        PG8_WAIT_V(6); PG8_BAR;
    } else {
        PG8_STAGE(PG8_SB(0, 0), cB, voffB); PG8_STAGE_A(0, 0, cA, vgc); PG8_STAGE(PG8_SB(0, 1), cB + hstepB, voffB); PG8_STAGE_A(0, 1, cA, vgc);
        if (wr == 1) PG8_BAR;
        PG8_WAIT_V(4); PG8_BAR;
        PG8_STAGE(PG8_SB(1, 0), cB + kstep, voffB); PG8_STAGE_A(1, 0, cA + kstep, vgc); PG8_STAGE(PG8_SB(1, 1), cB + hstepB + kstep, voffB);
        PG8_WAIT_V(6); PG8_BAR;
    }
    for (;;) {
        const bool has_next = S.next(ui + 1, nxt);
        const unsigned nA = has_next ? nxt.A : cA, nB = has_next ? nxt.B : cB;
#pragma unroll 1
        for (int t = 0; t < nt; t += 2) {
            const bool last = (t == nt - 2);
            const unsigned a1 = cA + (unsigned)(t + 1) * kstep;
            const unsigned a2 = last ? nA : cA + (unsigned)(t + 2) * kstep, b2 = last ? nB : cB + (unsigned)(t + 2) * kstep;
            const unsigned a3 = a2 + kstep, b3 = b2 + kstep;
            if constexpr (SP2) {
            PG8_LDB(B0, 0, 0); PG8_LDB(B1, 0, 1); PG8_SCHED; PG8_LDA(At, 0, 0); PG8_STAGE_A(1, 1, a1, vgc);
            if constexpr (GATHER) { if (last && has_next) PG8_GATHER_OFFS_LDS(nxt);
                if (t == 0 && has_next && wid == 0) __builtin_amdgcn_raw_ptr_buffer_load_lds(rsrc, (LAS unsigned*)idxL, 16, (int)(lane * 16), (int)nxt.rows_off, 0, 0); }
            PG8_WAIT_V(8); PG8_WAIT_L(0); PG8_BAR; PG8_MMA(0, 0, At, B0); PG8_MMA(0, 1, At, B1); PG8_BAR; PG8_SCHED;
            PG8_LDA(At, 0, 1); PG8_STAGE(PG8_SB(0, 0), b2, voffB); PG8_STAGE(PG8_SB(0, 1), b2 + hstepB, voffB); PG8_STAGE_A(0, 0, a2, vgc);
            PG8_WAIT_V(8); PG8_WAIT_L(0); PG8_BAR; PG8_MMA(1, 0, At, B0); PG8_MMA(1, 1, At, B1); PG8_BAR; PG8_SCHED;
            PG8_LDB(B0, 1, 0); PG8_LDB(B1, 1, 1); PG8_SCHED; PG8_LDA(At, 1, 0); PG8_STAGE_A(0, 1, a2, vgc);
            PG8_WAIT_V(8); PG8_WAIT_L(0); PG8_BAR; PG8_MMA(0, 0, At, B0); PG8_MMA(0, 1, At, B1); PG8_BAR; PG8_SCHED;
            PG8_LDA(At, 1, 1); PG8_STAGE(PG8_SB(1, 0), b3, voffB); PG8_STAGE(PG8_SB(1, 1), b3 + hstepB, voffB); PG8_STAGE_A(1, 0, a3, vgc);
            PG8_WAIT_V(8); PG8_WAIT_L(0); PG8_BAR; PG8_MMA(1, 0, At, B0); PG8_MMA(1, 1, At, B1); PG8_BAR; PG8_SCHED;
            } else {
            PG8_LDB(B0, 0, 0); PG8_SCHED; PG8_LDA(At, 0, 0); PG8_STAGE_A(1, 1, a1, vgc);
            if constexpr (GATHER) { if (last && has_next) PG8_GATHER_OFFS(nxt); }
            PG8_WAIT_L(8); PG8_BAR; PG8_WAIT_L(0); PG8_MMA(0, 0, At, B0); PG8_BAR; PG8_SCHED;
            PG8_LDB(B1, 0, 1); PG8_STAGE(PG8_SB(0, 0), b2, voffB);
            PG8_BAR; PG8_WAIT_L(0); PG8_MMA(0, 1, At, B1); PG8_BAR;
            PG8_LDA(At, 0, 1); PG8_STAGE_A(0, 0, a2, vgc);
            PG8_BAR; PG8_WAIT_L(0); PG8_MMA(1, 0, At, B0); PG8_BAR; PG8_SCHED;
            PG8_STAGE(PG8_SB(0, 1), b2 + hstepB, voffB);
            PG8_WAIT_V(6); PG8_BAR; PG8_MMA(1, 1, At, B1); PG8_BAR;
            PG8_LDB(B0, 1, 0); PG8_SCHED; PG8_LDA(At, 1, 0); PG8_STAGE_A(0, 1, a2, vgc);
            PG8_WAIT_L(8); PG8_BAR; PG8_WAIT_L(0); PG8_MMA(0, 0, At, B0); PG8_BAR; PG8_SCHED;
            PG8_LDB(B1, 1, 1); PG8_STAGE(PG8_SB(1, 0), b3, voffB);
            PG8_BAR; PG8_WAIT_L(0); PG8_MMA(0, 1, At, B1); PG8_BAR;
            PG8_LDA(At, 1, 1); PG8_STAGE_A(1, 0, a3, vgc);
            PG8_BAR; PG8_WAIT_L(0); PG8_MMA(1, 0, At, B0); PG8_BAR; PG8_SCHED;
            PG8_STAGE(PG8_SB(1, 1), b3 + hstepB, voffB);
            PG8_WAIT_V(6); PG8_BAR; PG8_MMA(1, 1, At, B1); PG8_BAR;
            }
        }
        if (wr == 0) PG8_BAR;
        if constexpr (!Epi::AFTER_DRAIN) E(acc, cur, wr, wc, fr, fq);
        if (!has_next) break;
#pragma unroll
        for (int a = 0; a < 2; ++a)
#pragma unroll
            for (int b = 0; b < 2; ++b)
#pragma unroll
                for (int m = 0; m < 4; ++m)
#pragma unroll
                    for (int n = 0; n < 2; ++n) acc[a][b][m][n] = (f32x4){0.f, 0.f, 0.f, 0.f};
        cur = nxt; cA = nA; cB = nB; ++ui;
        if (wr == 1) PG8_BAR;
    }
    PG8_WAIT_V(0);
    PG8_BAR;
    if constexpr (Epi::AFTER_DRAIN) E.fused(acc, cur, wr, wc, fr, fq, lds);
#undef PG8_SA
#undef PG8_SB
#undef PG8_STAGE
#undef PG8_STAGE_A
#undef PG8_GATHER_OFFS
#undef PG8_GATHER_OFFS_LDS
#undef PG8_LDA
#undef PG8_LDB
#undef PG8_MMA
#undef PG8_RD16
#undef PG8_WAIT_V
#undef PG8_WAIT_L
#undef PG8_BAR
#undef PG8_SCHED
}
}

struct DenseSched {
    unsigned A, B; int nM, nN, G, c; unsigned a_tile, b_tile; int pm_per_grp; unsigned b_grp;
    __device__ __forceinline__ bool next(int i, pg8::Unit& u) const {
        const long L = (long)i * G + c; if (L >= (long)nM * nN) return false;
        pg8::tile_of((int)L, nM, nN, u.pm, u.pn); u.aux = u.pm / pm_per_grp;
        u.A = A + (unsigned)u.pm * a_tile; u.B = B + (unsigned)u.aux * b_grp + (unsigned)u.pn * b_tile; u.rows = nullptr; u.rows_off = 0; u.nvalid = 0; return true;
    }
};
struct PanelSched {
    unsigned A, B; int pm, nN; unsigned a_tile, b_tile; int pm_per_grp; unsigned b_grp;
    __device__ __forceinline__ bool next(int i, pg8::Unit& u) const {
        if (i >= nN) return false;
        u.pm = pm; u.pn = i; u.aux = pm / pm_per_grp;
        u.A = A + (unsigned)pm * a_tile; u.B = B + (unsigned)u.aux * b_grp + (unsigned)i * b_tile; u.rows = nullptr; u.rows_off = 0; u.nvalid = 0; return true;
    }
};
struct MoeSched {
    unsigned A, B; const int* rows; const int* pb; int nM, nN, G, c; unsigned a_tile, b_tile, b_exp, rows_ws;
    __device__ __forceinline__ bool next(int i, pg8::Unit& u) const {
        const long L = (long)i * G + c; if (L >= (long)nM * nN) return false;
        pg8::tile_of((int)L, nM, nN, u.pm, u.pn);
        const int e = __builtin_amdgcn_readfirstlane(pb[132 + u.pm]);
        u.aux = e; u.A = A + (unsigned)u.pm * a_tile; u.B = B + (unsigned)e * b_exp + (unsigned)u.pn * b_tile;
        const int off = __builtin_amdgcn_readfirstlane(u.pm * 256 - pb[e]);
        u.rows = rows ? rows + (size_t)e * ECAP + off : nullptr; u.rows_off = rows_ws + ((unsigned)e * ECAP + (unsigned)off) * 4u; u.nvalid = __builtin_amdgcn_readfirstlane(pb[66 + e] - off); return true;
    }
};

#define EPI_ROWS_COLS_PERM() const int row0 = u.pm * 256 + wr * 64 + fr, col0 = u.pn * 256 + wc * 32 + 8 * fq
__device__ __forceinline__ u32x4 pack8(const f32x4 v0, const f32x4 v1) { u32x4 w; w.x = pg8::cvt_pk_bf16(v0[0], v0[1]); w.y = pg8::cvt_pk_bf16(v0[2], v0[3]); w.z = pg8::cvt_pk_bf16(v1[0], v1[1]); w.w = pg8::cvt_pk_bf16(v1[2], v1[3]); return w; }
struct EpiProj {
    static constexpr bool PERM = true, AFTER_DRAIN = false;
    bf16 *Q, *UA;
    __device__ __forceinline__ void operator()(const f32x4 (&acc)[2][2][4][2], const pg8::Unit& u, int wr, int wc, int fr, int fq) const {
        EPI_ROWS_COLS_PERM();
        const int sel = u.pn >> 1;
        const float sc = sel == 0 ? 0.125f : 1.0f;
#pragma unroll
        for (int ai = 0; ai < 2; ++ai)
#pragma unroll
            for (int m = 0; m < 4; ++m) { const int r = row0 + ai * 128 + m * 16;
#pragma unroll
                for (int bj = 0; bj < 2; ++bj) { const int c = col0 + bj * 128; const u32x4 w = pack8(acc[ai][bj][m][0] * sc, acc[ai][bj][m][1] * sc);
                    if (sel < 3) { bf16* base = Q + (size_t)sel * ((WS_K - WS_Q) / 2); *(u32x4*)(base + (size_t)r * AW + (c & 511)) = w; }
                    else { const int cc = c - 1536, g = cc >> 4; *(u32x4*)(UA + ((size_t)g * NBLK + (r >> 5)) * UAW + (r & 31) * SC + (cc & 15)) = w; } } }
    }
};
struct EpiGlu {
    static constexpr bool PERM = true, AFTER_DRAIN = false;
    const bf16* G; bf16* MIX; const float* bias;
    __device__ __forceinline__ void operator()(const f32x4 (&acc)[2][2][4][2], const pg8::Unit& u, int wr, int wc, int fr, int fq) const {
        EPI_ROWS_COLS_PERM();
        u32x4 gwv[2][4][2];
#pragma unroll
        for (int ai = 0; ai < 2; ++ai)
#pragma unroll
            for (int m = 0; m < 4; ++m)
#pragma unroll
                for (int bj = 0; bj < 2; ++bj) gwv[ai][m][bj] = *(const u32x4*)(G + (size_t)(row0 + ai * 128 + m * 16) * SW + col0 + bj * 128);
#pragma unroll
        for (int bj = 0; bj < 2; ++bj) { const int c = col0 + bj * 128; const f32x4 b0 = *(const f32x4*)(bias + c), b1 = *(const f32x4*)(bias + c + 4);
#pragma unroll
            for (int ai = 0; ai < 2; ++ai)
#pragma unroll
                for (int m = 0; m < 4; ++m) { const int r = row0 + ai * 128 + m * 16;
                    const u32x4 gw = gwv[ai][m][bj]; f32x4 o0, o1;
#pragma unroll
                    for (int e = 0; e < 2; ++e) { o0[2 * e] = __uint_as_float(gw[e] << 16) * sigmoidf_(acc[ai][bj][m][0][2 * e] + b0[2 * e]); o0[2 * e + 1] = __uint_as_float(gw[e] & 0xffff0000u) * sigmoidf_(acc[ai][bj][m][0][2 * e + 1] + b0[2 * e + 1]);
                        o1[2 * e] = __uint_as_float(gw[2 + e] << 16) * sigmoidf_(acc[ai][bj][m][1][2 * e] + b1[2 * e]); o1[2 * e + 1] = __uint_as_float(gw[2 + e] & 0xffff0000u) * sigmoidf_(acc[ai][bj][m][1][2 * e + 1] + b1[2 * e + 1]); }
                    *(u32x4*)(MIX + (size_t)r * D + AW + c) = pack8(o0, o1); } }
    }
};
struct EpiWout {
    static constexpr bool PERM = true, AFTER_DRAIN = false;
    bf16* Z1; f32x2_t* STATS;
    __device__ __forceinline__ void operator()(const f32x4 (&acc)[2][2][4][2], const pg8::Unit& u, int wr, int wc, int fr, int fq) const {
        EPI_ROWS_COLS_PERM();
        u32x4 xw[2][4][2];
#pragma unroll
        for (int ai = 0; ai < 2; ++ai)
#pragma unroll
            for (int m = 0; m < 4; ++m)
#pragma unroll
                for (int bj = 0; bj < 2; ++bj) xw[ai][m][bj] = *(const u32x4*)(Z1 + (size_t)(row0 + ai * 128 + m * 16) * D + col0 + bj * 128);
#pragma unroll
        for (int ai = 0; ai < 2; ++ai)
#pragma unroll
            for (int m = 0; m < 4; ++m) { const int r = row0 + ai * 128 + m * 16; float s1 = 0.f, s2 = 0.f;
#pragma unroll
                for (int bj = 0; bj < 2; ++bj) { const int c = col0 + bj * 128; const u32x4 w = xw[ai][m][bj]; f32x4 x0, x1;
                    x0[0] = __uint_as_float(w[0] << 16); x0[1] = __uint_as_float(w[0] & 0xffff0000u); x0[2] = __uint_as_float(w[1] << 16); x0[3] = __uint_as_float(w[1] & 0xffff0000u);
                    x1[0] = __uint_as_float(w[2] << 16); x1[1] = __uint_as_float(w[2] & 0xffff0000u); x1[2] = __uint_as_float(w[3] << 16); x1[3] = __uint_as_float(w[3] & 0xffff0000u);
                    const f32x4 z0 = x0 * ALPHA + acc[ai][bj][m][0], z1 = x1 * ALPHA + acc[ai][bj][m][1];
#pragma unroll
                    for (int e = 0; e < 4; ++e) { s1 += z0[e] + z1[e]; s2 += z0[e] * z0[e] + z1[e] * z1[e]; }
                    *(u32x4*)(Z1 + (size_t)r * D + c) = pack8(z0, z1); }
                s1 = xadd32(xadd16(s1)); s2 = xadd32(xadd16(s2));
                if (fq == 0) { f32x2_t w; w[0] = s1; w[1] = s2; STATS[(size_t)(u.pn * 4 + wc) * T + r] = w; } }
    }
};
struct EpiGateUp {
    static constexpr bool PERM = true, AFTER_DRAIN = false; static constexpr int SCALE_A = 0x7f7f7f7f, SCALE_B = 0x7f7f7f7f;
    fp8* HID;
    __device__ __forceinline__ void operator()(const f32x4 (&acc)[2][2][4][2], const pg8::Unit& u, int wr, int wc, int fr, int fq) const {
        const int row0 = u.pm * 256 + wr * 64 + fr, col0 = u.pn * 128 + wc * 32 + 8 * fq;
#pragma unroll
        for (int ai = 0; ai < 2; ++ai)
#pragma unroll
            for (int m = 0; m < 4; ++m) { const int r = row0 + ai * 128 + m * 16; f32x4 o[2];
#pragma unroll
                for (int n = 0; n < 2; ++n)
#pragma unroll
                    for (int e = 0; e < 4; ++e) { const float gt = acc[ai][0][m][n][e] * 0.03125f; o[n][e] = gt * sigmoidf_(gt) * (acc[ai][1][m][n][e] * 0.03125f); }
                u32x2 w; w.x = pk4_fp8(o[0][0], o[0][1], o[0][2], o[0][3]); w.y = pk4_fp8(o[1][0], o[1][1], o[1][2], o[1][3]);
                *(u32x2*)(HID + (size_t)r * DE + col0) = w; }
    }
};
struct EpiDown {
    static constexpr bool PERM = true, AFTER_DRAIN = false; static constexpr int SCALE_A = 0x7f7f7f7f, SCALE_B = 0x7f7f7f7f;
    fp8* O;
    __device__ __forceinline__ void operator()(const f32x4 (&acc)[2][2][4][2], const pg8::Unit& u, int wr, int wc, int fr, int fq) const {
        EPI_ROWS_COLS_PERM();
#pragma unroll
        for (int ai = 0; ai < 2; ++ai)
#pragma unroll
            for (int m = 0; m < 4; ++m) { const int r = row0 + ai * 128 + m * 16;
#pragma unroll
                for (int bj = 0; bj < 2; ++bj) { const f32x4 a = acc[ai][bj][m][0] * 0.25f, b = acc[ai][bj][m][1] * 0.25f; u32x2 w; w.x = pk4_fp8(a[0], a[1], a[2], a[3]); w.y = pk4_fp8(b[0], b[1], b[2], b[3]);
                    *(u32x2*)(O + (size_t)r * D + col0 + bj * 128) = w; } }
    }
};

struct CvtItem { const float* W; bf16* WT; int ldw, ldt, k0, n0, drow0; };
__device__ __forceinline__ void cvt_load(const CvtItem& c, f32x4 (&v)[16], int lane) {
    const int rq = lane >> 4, cq = (lane & 15) * 4;
#pragma unroll
    for (int i = 0; i < 16; ++i) v[i] = *(const f32x4*)(c.W + (size_t)(c.k0 + 8 * (i >> 1) + 2 * rq + (i & 1)) * c.ldw + c.n0 + cq);
}
__device__ __forceinline__ void cvt_store(const CvtItem& c, const f32x4 (&v)[16], LAS unsigned char* tile, int lane) {
    const int rq = lane >> 4, l15 = lane & 15, sw = (l15 & 7) << 2;
#pragma unroll
    for (int m = 0; m < 8; ++m)
#pragma unroll
        for (int e = 0; e < 4; ++e) *(LAS unsigned*)(tile + (4 * l15 + e) * 128 + (((4 * m + rq) ^ sw) << 2)) = pk2(v[2 * m][e], v[2 * m + 1][e]);
    asm volatile("s_waitcnt lgkmcnt(0)" ::: "memory");
    const int ch = lane & 7;
#pragma unroll
    for (int j = 0; j < 8; ++j) { const int n = (lane >> 3) + 8 * j;
        const u32x4 o = *(const LAS u32x4*)(tile + n * 128 + ((ch ^ ((n >> 2) & 7)) << 4));
        *(u32x4*)(c.WT + (size_t)(c.drow0 + n) * c.ldt + c.k0 + 8 * ch) = o; }
    asm volatile("s_waitcnt lgkmcnt(0)" ::: "memory");
}
struct CvtItem8 { const float* W; fp8* WT; int ldw, ldt, k0, n0, drow0; };
__device__ __forceinline__ void cvt8_load(const CvtItem8& c, f32x4 (&v)[16], int lane) {
    const int rq = lane >> 4, cq = (lane & 15) * 4;
#pragma unroll
    for (int i = 0; i < 16; ++i) v[i] = *(const f32x4*)(c.W + (size_t)(c.k0 + 16 * (i >> 2) + 4 * rq + (i & 3)) * c.ldw + c.n0 + cq);
}
__device__ __forceinline__ void cvt8_store(const CvtItem8& c, const f32x4 (&v)[16], LAS unsigned char* tile, int lane) {
    const int rq = lane >> 4, l15 = lane & 15, sw = l15 & 3;
#pragma unroll
    for (int m = 0; m < 4; ++m)
#pragma unroll
        for (int e = 0; e < 4; ++e) *(LAS unsigned*)(tile + (4 * l15 + e) * 64 + ((m ^ sw) << 4) + (rq << 2)) = pk4_fp8(v[4 * m][e] * 32.f, v[4 * m + 1][e] * 32.f, v[4 * m + 2][e] * 32.f, v[4 * m + 3][e] * 32.f);
    asm volatile("s_waitcnt lgkmcnt(0)" ::: "memory");
    const int ch = lane & 3;
#pragma unroll
    for (int j = 0; j < 4; ++j) { const int n = (lane >> 2) + 16 * j;
        const u32x4 o = *(const LAS u32x4*)(tile + n * 64 + ((ch ^ ((n >> 2) & 3)) << 4));
        *(u32x4*)(c.WT + (size_t)(c.drow0 + n) * c.ldt + c.k0 + 16 * ch) = o; }
    asm volatile("s_waitcnt lgkmcnt(0)" ::: "memory");
}
__device__ __forceinline__ void p0_item(const float* W, int ldw, bf16* WT, int ldt, int k0, int n0, int drow0, LAS unsigned char* tile, int lane) {
    CvtItem c; c.W = W; c.WT = WT; c.ldw = ldw; c.ldt = ldt; c.k0 = k0; c.n0 = n0; c.drow0 = drow0;
    f32x4 v[16]; cvt_load(c, v, lane); cvt_store(c, v, tile, lane);
}
__device__ __forceinline__ void p0_prologue(Frame& F) {
    LAS unsigned char* scr = (LAS unsigned char*)F.lds + F.wave * 16896;
    const int gw = F.bid * NWAVES + F.wave, NGW = F.G * NWAVES, lane = F.lane;
    bf16* WIN_T = (bf16*)(F.ws + WS_WIN_T); bf16* WGLU_T = (bf16*)(F.ws + WS_WGLU_T); bf16* WOUT_T = (bf16*)(F.ws + WS_WOUT_T); bf16* XB = (bf16*)(F.ws + WS_XB);
    constexpr int I_IN = 16 * 32, I_GL = 8 * 8, I_OUT = 16 * 16, NITEMS = I_IN + I_GL + I_OUT;
    for (int it = gw; it < NITEMS; it += NGW) {
        int r = it;
        if (r < I_IN) { const int kb = r / 32, nb = r % 32; p0_item(F.in[I_WIN], INW, WIN_T, D, kb * 64, nb * 64, nb * 64, scr, lane); continue; } r -= I_IN;
        if (r < I_GL) { const int kb = r / 8, nb = r % 8; p0_item(F.in[I_WGLU], SW, WGLU_T, SW, kb * 64, nb * 64, nb * 64, scr, lane); continue; } r -= I_GL;
        { const int kb = r / 16, nb = r % 16; p0_item(F.in[I_WOUT], D, WOUT_T, D, kb * 64, nb * 64, nb * 64, scr, lane); }
    }
    { bf16* WRT = (bf16*)(F.ws + WS_WR_T);
      for (int i = F.bid * NTHR + F.tid; i < 72 * D; i += F.G * NTHR) { const int n = i >> 10, k = i & 1023; WRT[i] = f2bf(n < 64 ? F.in[I_WRE][(size_t)k * NE + n] : F.in[I_WRG][(size_t)k * NEG + n - 64]); } }
    const float* x = F.in[I_X];
    int* qslot = (int*)(F.lds + 8 * 16896);
    __syncthreads();
    if (F.tid == 0) qslot[0] = (int)__hip_atomic_fetch_add(&F.ctl[CW_XQ], 1u, __ATOMIC_RELAXED, __HIP_MEMORY_SCOPE_AGENT);
    __syncthreads();
    for (int par = 0;; par ^= 1) {
        const int ch = qslot[par];
        if (ch >= T / 32) break;
        if (F.tid == 0) qslot[par ^ 1] = (int)__hip_atomic_fetch_add(&F.ctl[CW_XQ], 1u, __ATOMIC_RELAXED, __HIP_MEMORY_SCOPE_AGENT);
        const size_t base = (size_t)ch * 32 * D + (size_t)F.tid * 8;
        f32x4 a[8], b2[8];
#pragma unroll
        for (int j = 0; j < 8; ++j) { a[j] = *(const f32x4*)(x + base + j * 4096); b2[j] = *(const f32x4*)(x + base + j * 4096 + 4); }
#pragma unroll
        for (int j = 0; j < 8; ++j) { u32x4 o; o.x = pk2(a[j][0], a[j][1]); o.y = pk2(a[j][2], a[j][3]); o.z = pk2(b2[j][0], b2[j][1]); o.w = pk2(b2[j][2], b2[j][3]); *(u32x4*)(XB + base + j * 4096) = o; }
        __syncthreads();
    }
}
__device__ __forceinline__ CvtItem8 moe_item(Frame& F, int it) {
    constexpr int I_EXP = 16 * 8 + 16 * 8 + 8 * 16;
    fp8* WGU = (fp8*)(F.ws + WS_WGU_T); fp8* WDN = (fp8*)(F.ws + WS_WDN_T);
    const int e = it / I_EXP; int r = it - e * I_EXP; CvtItem8 c;
    if (r < 256) { const bool up = r >= 128; r &= 127; const int kb = r / 8, nb = r % 8, n0 = nb * 64;
        c.W = (up ? F.in[I_WUP] : F.in[I_WGATE]) + (size_t)e * D * DE; c.ldw = DE; c.WT = WGU + (size_t)e * 1024 * D; c.ldt = D; c.k0 = kb * 64; c.n0 = n0; c.drow0 = 256 * (n0 >> 7) + (up ? 128 : 0) + (n0 & 127); }
    else { r -= 256; const int kb = r / 16, nb = r % 16; c.W = F.in[I_WDOWN] + (size_t)e * DE * D; c.ldw = D; c.WT = WDN + (size_t)e * D * DE; c.ldt = DE; c.k0 = kb * 64; c.n0 = nb * 64; c.drow0 = nb * 64; }
    return c;
}

constexpr int MOE_NGRP = NE * (16 * 8 + 16 * 8 + 8 * 16) / 8;
__device__ __forceinline__ void moe_fill_group(Frame& F, int grp) {
    LAS unsigned char* scr = (LAS unsigned char*)F.lds + F.wave * 16896;
    const CvtItem8 c = moe_item(F, grp * 8 + F.wave);
    f32x4 v[16]; cvt8_load(c, v, F.lane); cvt8_store(c, v, scr, F.lane);
}
__device__ __forceinline__ void moe_drain(Frame& F) {
    LAS int* slot = (LAS int*)((LAS unsigned char*)F.lds + 8 * 16896);
    for (;;) {
        __syncthreads();
        if (F.tid == 0) slot[0] = (int)__hip_atomic_fetch_add(&F.ctl[CW_MQ], 1u, __ATOMIC_RELAXED, __HIP_MEMORY_SCOPE_AGENT);
        __syncthreads();
        const int grp = slot[0];
        if (grp >= MOE_NGRP) break;
        moe_fill_group(F, grp);
    }
    __syncthreads();
}
__device__ __forceinline__ void xcd_barrier_fill(const XcdBarrier& b, Frame& F) {
    asm volatile("s_waitcnt vmcnt(0)" ::: "memory");
    __syncthreads();
    volatile LAS int* role = (volatile LAS int*)((LAS unsigned char*)F.lds + 8 * 16896 + 64);
    unsigned* bar = b.bar;
    if (threadIdx.x == 0) {
        __builtin_amdgcn_s_waitcnt(0);
        unsigned nloc = b.st[0], nx = b.st[1];
        if (nloc == 0u) { xcd_barrier_complete(bar, b.x, nloc, nx); b.st[0] = nloc; b.st[1] = nx; }
        const unsigned old = xb_add(&bar[XB_XSUB(b.x)], 1u);
        const unsigned gen = old / nloc;
        const bool leader = (old + 1u == (gen + 1u) * nloc);
        role[0] = leader ? 1 : 0; role[1] = (int)gen;
        if (leader) {
            __builtin_amdgcn_fence(__ATOMIC_RELEASE, "agent");
            asm volatile("s_waitcnt vmcnt(0)" ::: "memory");
            const unsigned og = xb_add(&bar[XB_TOP], 1u);
            const unsigned tg = og / nx;
            if (og + 1u == (tg + 1u) * nx) xb_add(&bar[XB_TOPGEN], 1u);
            else XB_SPIN(xb_ld(&bar[XB_TOPGEN]) == tg, bar);
            __builtin_amdgcn_fence(__ATOMIC_ACQUIRE, "agent");
            xb_add(&bar[XB_XGEN(b.x)], 1u);
            asm volatile("s_waitcnt vmcnt(0)" ::: "memory");
        }
    }
    __syncthreads();
    if (role[0] == 0) {
        unsigned spins = 0;
        for (;;) {
            if (threadIdx.x == 0) {
                const unsigned gen = (unsigned)role[1];
                bool done = xb_ld(&bar[XB_XGEN(b.x)]) != gen;
                if (!done && ((++spins & 1023u) == 0u)) { if (xb_ld(&bar[XB_TMO])) done = true; else if (spins > XB_SPIN_CAP) { atomicAdd(&bar[XB_TMO], 1u); done = true; } }
                int grp = -1;
                if (!done) {
                    const unsigned nloc = b.st[0], nx = b.st[1];
                    const unsigned loc = xb_ld(&bar[XB_XSUB(b.x)]) - gen * nloc, top = xb_ld(&bar[XB_TOP]) - gen * nx;
                    if ((loc < nloc || top + 1u < nx) && xb_ld(&F.ctl[CW_MQ]) < (unsigned)MOE_NGRP) { const unsigned g_ = xb_add(&F.ctl[CW_MQ], 1u); if (g_ < (unsigned)MOE_NGRP) grp = (int)g_; }
                }
                role[2] = done ? 1 : 0; role[3] = grp;
            }
            __syncthreads();
            const int done = role[2], grp = role[3];
            if (done) break;
            if (grp >= 0) moe_fill_group(F, grp); else __builtin_amdgcn_s_sleep(4);
            __syncthreads();
        }
        if (threadIdx.x == 0) { __builtin_amdgcn_fence(__ATOMIC_ACQUIRE, "agent"); asm volatile("s_waitcnt vmcnt(0)" ::: "memory"); }
    }
    __syncthreads();
}

__device__ __forceinline__ void p0_s5tables_group(Frame& F, int g, int q) {
    float* PWr = (float*)F.lds;
    float* PWi = PWr + 2 * 64 * 33;
    float* BBr = PWi + 2 * 64 * 33;
    float* BBi = BBr + 2 * 64 * 16;
    float* Cr = BBi + 2 * 64 * 16;
    float* Ci = Cr + 2 * 16 * 64;
    float* KL = Ci + 2 * 16 * 64;
    float* C2r = KL + 64 * 257;
    float* C2i = C2r + 2 * 16 * 64;
    const int tid = F.tid;
    __syncthreads();
    if (tid < 128) {
        const int d = tid >> 6, p = tid & 63;
        const float ar = F.in[I_ARE][(d * SG + g) * SP + p], ai = F.in[I_AIM][(d * SG + g) * SP + p];
        const float dt = expf(F.in[I_LDT][d * SG + g]);
        const float mag = expf(ar * dt), lr = mag * cosf(ai * dt), li = mag * sinf(ai * dt);
        float pr = 1.0f, pi = 0.0f;
        for (int j = 0; j <= 32; ++j) { PWr[(d * 64 + p) * 33 + j] = pr; PWi[(d * 64 + p) * 33 + j] = pi; const float nr = pr * lr - pi * li, ni = pr * li + pi * lr; pr = nr; pi = ni; }
        const float den = ar * ar + ai * ai;
        const float zr = ((lr - 1.0f) * ar + li * ai) / den, zi = (li * ar - (lr - 1.0f) * ai) / den;
        for (int c = 0; c < SC; ++c) {
            const float br = F.in[I_BRE][((size_t)(d * SG + g) * SP + p) * SC + c], bi = F.in[I_BIM][((size_t)(d * SG + g) * SP + p) * SC + c];
            BBr[(d * 64 + p) * 16 + c] = zr * br - zi * bi; BBi[(d * 64 + p) * 16 + c] = zr * bi + zi * br;
            const float crv = F.in[I_CRE][((size_t)(d * SG + g) * SC + c) * SP + p], civ = F.in[I_CIM][((size_t)(d * SG + g) * SC + c) * SP + p];
            Cr[(d * 64 + p) * 16 + c] = crv; Ci[(d * 64 + p) * 16 + c] = civ; C2r[(d * 16 + c) * 64 + p] = crv; C2i[(d * 16 + c) * 64 + p] = civ;
        }
    }
    __syncthreads();
    for (int idx = tid; idx < 1024; idx += NTHR) {
        const int d = idx >> 9, j = (idx >> 4) & 31, c = idx & 15;
        if (d == 0 ? (j > 8 * q + 7) : (j > 31 - 8 * q)) continue;
        float acc[16];
#pragma unroll
        for (int q = 0; q < 16; ++q) acc[q] = 0.f;
        for (int p = 0; p < 64; ++p) {
            const float cr = Cr[(d * 64 + p) * 16 + c], ci = Ci[(d * 64 + p) * 16 + c], pr = PWr[(d * 64 + p) * 33 + j], pi = PWi[(d * 64 + p) * 33 + j];
            const float mr = cr * pr - ci * pi, mi = cr * pi + ci * pr;
            const f32x4* br4 = (const f32x4*)(BBr + (d * 64 + p) * 16); const f32x4* bi4 = (const f32x4*)(BBi + (d * 64 + p) * 16);
#pragma unroll
            for (int q = 0; q < 4; ++q) { const f32x4 br = br4[q], bi = bi4[q];
#pragma unroll
                for (int e = 0; e < 4; ++e) acc[4 * q + e] += mr * br[e] - mi * bi[e]; }
        }
#pragma unroll
        for (int q = 0; q < 16; ++q) KL[(d * 32 + j) * 257 + c * 16 + q] = acc[q];
    }
    __syncthreads();
    for (int part = 2 * q; part < 2 * q + 2; ++part) {
    bf16* KY = (bf16*)(F.ws + WS_KY) + (size_t)g * 512 * UAW;
    for (int o = tid; o < 64 * 64; o += NTHR) {
        const int rr = o >> 6, k0 = (o & 63) * 8, n = 64 * part + rr, t = n >> 4, c = n & 15;
        float v[8];
#pragma unroll
        for (int e = 0; e < 8; ++e) {
            const int k = k0 + e, sI = k >> 4, c2 = k & 15;
            float val = (sI <= t ? KL[(0 * 32 + (t - sI)) * 257 + c * 16 + c2] : 0.f) + (sI >= t ? KL[(1 * 32 + (sI - t)) * 257 + c * 16 + c2] : 0.f);
            if (sI == t && c == c2) val += F.in[I_SD][g * SC + c];
            v[e] = val;
        }
        u32x4 w; w.x = pk2(v[0], v[1]); w.y = pk2(v[2], v[3]); w.z = pk2(v[4], v[5]); w.w = pk2(v[6], v[7]);
        *(u32x4*)(KY + (size_t)n * UAW + k0) = w;
    }
    for (int o = tid; o < 64 * 4 * 64; o += NTHR) {
        const int p = o & 63, seg = (o >> 6) & 3, rr = o >> 8, n = 64 * part + rr, t = n >> 4, c = n & 15, d = seg >> 1, im = seg & 1, j = d == 0 ? t + 1 : 32 - t;
        const float cr = C2r[(d * 16 + c) * 64 + p], ci = C2i[(d * 16 + c) * 64 + p], pr = PWr[(d * 64 + p) * 33 + j], pi = PWi[(d * 64 + p) * 33 + j];
        KY[(size_t)n * UAW + 512 + seg * 64 + p] = f2bf(im ? -(cr * pi + ci * pr) : (cr * pr - ci * pi));
    }
    bf16* WE = (bf16*)(F.ws + WS_WE) + (size_t)g * 256 * 512;
    for (int o = tid; o < 32 * 64; o += NTHR) {
        const int rr = o >> 6, k0 = (o & 63) * 8, n = 32 * part + rr, seg = n >> 6, p = n & 63, d = seg >> 1, im = seg & 1;
        float v[8];
#pragma unroll
        for (int e = 0; e < 8; ++e) { const int k = k0 + e, sI = k >> 4, c2 = k & 15, j = d == 0 ? 31 - sI : sI;
            const float pr = PWr[(d * 64 + p) * 33 + j], pi = PWi[(d * 64 + p) * 33 + j], br = BBr[(d * 64 + p) * 16 + c2], bi = BBi[(d * 64 + p) * 16 + c2];
            v[e] = im ? (pr * bi + pi * br) : (pr * br - pi * bi); }
        u32x4 w; w.x = pk2(v[0], v[1]); w.y = pk2(v[2], v[3]); w.z = pk2(v[4], v[5]); w.w = pk2(v[6], v[7]);
        *(u32x4*)(WE + (size_t)n * 512 + k0) = w;
    }
    }
    if (q == 0 && tid < 128) { const int d = tid >> 6, p = tid & 63; float* L = (float*)(F.ws + WS_S5TAB) + ((size_t)(g * 2 + d) * 64 + p) * 2; L[0] = PWr[(d * 64 + p) * 33 + 32]; L[1] = PWi[(d * 64 + p) * 33 + 32]; }
    __syncthreads();
}
__device__ __forceinline__ void p0_s5tables(Frame& F) { for (int it = F.bid; it < SG * 4; it += F.G) p0_s5tables_group(F, it >> 2, it & 3); }

struct EpiS5E {
    static constexpr bool PERM = false, AFTER_DRAIN = false;
    float* E;
    __device__ __forceinline__ void operator()(const f32x4 (&acc)[2][2][4][2], const pg8::Unit& u, int wr, int wc, int fr, int fq) const {
        const int row0 = u.pm * 256 + wr * 64 + fr, col0 = wc * 32 + 4 * fq;
#pragma unroll
        for (int ai = 0; ai < 2; ++ai)
#pragma unroll
            for (int m = 0; m < 4; ++m) { float* rowp = E + (size_t)(row0 + ai * 128 + m * 16) * 256 + col0;
#pragma unroll
                for (int bj = 0; bj < 2; ++bj)
#pragma unroll
                    for (int n = 0; n < 2; ++n) *(f32x4*)(rowp + bj * 128 + n * 16) = acc[ai][bj][m][n]; }
    }
};
struct EpiS5Y {
    static constexpr bool PERM = true, AFTER_DRAIN = false;
    bf16* G;
    __device__ __forceinline__ void operator()(const f32x4 (&acc)[2][2][4][2], const pg8::Unit& u, int wr, int wc, int fr, int fq) const {
        EPI_ROWS_COLS_PERM();
#pragma unroll
        for (int ai = 0; ai < 2; ++ai)
#pragma unroll
            for (int m = 0; m < 4; ++m) { const int r = row0 + ai * 128 + m * 16, g = r >> 11, blk = r & 2047;
#pragma unroll
                for (int bj = 0; bj < 2; ++bj) { const int c = col0 + bj * 128, t = c >> 4, ch = c & 15; f32x4 o0, o1;
#pragma unroll
                    for (int e = 0; e < 4; ++e) { o0[e] = gelu_tanh(acc[ai][bj][m][0][e]); o1[e] = gelu_tanh(acc[ai][bj][m][1][e]); }
                    *(u32x4*)(G + ((size_t)blk * TB + t) * SW + g * SC + ch) = pack8(o0, o1); } }
    }
};

struct EpiS5EScan {
    static constexpr bool PERM = false, AFTER_DRAIN = true;
    bf16* UA; const float* L32;
    __device__ __forceinline__ void fused(const f32x4 (&acc)[2][2][4][2], const pg8::Unit& u, int wr, int wc, int fr, int fq, LAS unsigned char* lds) const {
        LAS float* Eb = (LAS float*)lds;
        const int g = u.pm >> 3, p = threadIdx.x & 63;
        const size_t rowbase = (size_t)u.pm * 256;
#pragma unroll
        for (int d = 0; d < 2; ++d) {
#pragma unroll
            for (int ai = 0; ai < 2; ++ai)
#pragma unroll
                for (int m = 0; m < 4; ++m)
#pragma unroll
                    for (int n = 0; n < 2; ++n) *(LAS f32x4*)(Eb + (ai * 128 + wr * 64 + m * 16 + fr) * 128 + wc * 32 + n * 16 + 4 * fq) = acc[ai][d][m][n];
            __syncthreads();
            if (threadIdx.x < 64) {
                const float lr = L32[((size_t)(g * 2 + d) * 64 + p) * 2], li = L32[((size_t)(g * 2 + d) * 64 + p) * 2 + 1];
                float hr = 0.f, hi = 0.f;
                for (int k0 = 0; k0 < 256; k0 += 8) {
                    float er[8], ei[8];
#pragma unroll
                    for (int i = 0; i < 8; ++i) { const int k = d == 0 ? k0 + i : 255 - (k0 + i); er[i] = Eb[k * 128 + p]; ei[i] = Eb[k * 128 + 64 + p]; }
#pragma unroll
                    for (int i = 0; i < 8; ++i) { const int k = d == 0 ? k0 + i : 255 - (k0 + i);
                        bf16* o = UA + (rowbase + k) * UAW + 512 + d * 128; o[p] = f2bf(hr); o[64 + p] = f2bf(hi);
                        const float nr = lr * hr - li * hi + er[i], ni = lr * hi + li * hr + ei[i]; hr = nr; hi = ni; }
                }
            }
            __syncthreads();
        }
    }
};
__device__ __forceinline__ void f_s5e(Frame& F) {
    DenseSched S{(unsigned)WS_UA, (unsigned)WS_WE, T / 256, 1, F.G, F.bid, 256u * UAW * 2, 0u, 8, 256u * 512 * 2};
    if (F.G >= T / 256) {
        EpiS5EScan E{(bf16*)(F.ws + WS_UA), (const float*)(F.ws + WS_S5TAB)};
        pg8::gemm_phase<EpiS5EScan, DenseSched, false>((LAS unsigned char*)F.lds, F.ws, UAW * 2, 512 * 2, 512 / 64, S, E);
        if (F.bid < T / 256) {
            int pm, pn; pg8::tile_of(F.bid, T / 256, 1, pm, pn);
            asm volatile("s_waitcnt vmcnt(0)" ::: "memory");
            __syncthreads();
            PanelSched S2{(unsigned)WS_UA, (unsigned)WS_KY, pm, 2, 256u * UAW * 2, 256u * UAW * 2, 8, 512u * UAW * 2};
            EpiS5Y E2{(bf16*)(F.ws + WS_G)};
            pg8::gemm_phase<EpiS5Y, PanelSched, false, false, ENG_SP2>((LAS unsigned char*)F.lds, F.ws, UAW * 2, UAW * 2, UAW / 64, S2, E2);
        }
    } else {
        EpiS5E E{(float*)(F.ws + WS_E)};
        pg8::gemm_phase<EpiS5E, DenseSched, false>((LAS unsigned char*)F.lds, F.ws, UAW * 2, 512 * 2, 512 / 64, S, E);
    }
}
__device__ __forceinline__ void f_s5y(Frame& F) {
    DenseSched S{(unsigned)WS_UA, (unsigned)WS_KY, T / 256, 2, F.G, F.bid, 256u * UAW * 2, 256u * UAW * 2, 8, 512u * UAW * 2};
    EpiS5Y E{(bf16*)(F.ws + WS_G)};
    pg8::gemm_phase<EpiS5Y, DenseSched, false, false, ENG_SP2>((LAS unsigned char*)F.lds, F.ws, UAW * 2, UAW * 2, UAW / 64, S, E);
}
__device__ __forceinline__ void f_s5scan(Frame& F) {
    const float* E = (const float*)(F.ws + WS_E); bf16* UA = (bf16*)(F.ws + WS_UA); const float* L32 = (const float*)(F.ws + WS_S5TAB);
    const int per = (NBATCH * SG * 2 * SP + F.G - 1) / F.G;
    if (F.tid >= per) return;
    const int id = F.bid * per + F.tid; if (id >= NBATCH * SG * 2 * SP) return;
    const int p = id & 63, d = (id >> 6) & 1, g = (id >> 7) & 31, b = id >> 12;
    const float lr = L32[((size_t)(g * 2 + d) * 64 + p) * 2], li = L32[((size_t)(g * 2 + d) * 64 + p) * 2 + 1];
    float hr = 0.f, hi = 0.f;
    const size_t rowbase = (size_t)g * NBLK + (size_t)b * 256;
    const int colr = d * 128 + p, coli = colr + 64;
    for (int k0 = 0; k0 < 256; k0 += 8) {
        float er[8], ei[8];
#pragma unroll
        for (int i = 0; i < 8; ++i) { const int k = d == 0 ? k0 + i : 255 - (k0 + i); er[i] = E[(rowbase + k) * 256 + colr]; ei[i] = E[(rowbase + k) * 256 + coli]; }
#pragma unroll
        for (int i = 0; i < 8; ++i) { const int k = d == 0 ? k0 + i : 255 - (k0 + i);
            bf16* o = UA + (rowbase + k) * UAW + 512; o[colr] = f2bf(hr); o[coli] = f2bf(hi);
            const float nr = lr * hr - li * hi + er[i], ni = lr * hi + li * hr + ei[i]; hr = nr; hi = ni; }
    }
}


__device__ __forceinline__ s16x4 vtr(LAS const unsigned char* p) { return __builtin_bit_cast(s16x4, __builtin_amdgcn_ds_read_tr16_b64_v4i16((LAS s16x4*)p)); }
__device__ __forceinline__ void f_attn(Frame& F) {
    LAS unsigned char* L = (LAS unsigned char*)F.lds;
    constexpr int RSL = 5120, NSL = 15, KOFF = 0, VOFF = NSL * RSL, ROFF = 2 * NSL * RSL;
    const bf16* Q = (const bf16*)(F.ws + WS_Q); const bf16* Kb = (const bf16*)(F.ws + WS_K); const bf16* Vb = (const bf16*)(F.ws + WS_V);
    bf16* MIX = (bf16*)(F.ws + WS_MIX); const float* rpb = F.in[I_RPB];
    LAS float* rpbL = (LAS float*)(L + ROFF);
    const int w = F.wave, lane = F.lane, g = lane >> 4, li = lane & 15, ro = w >> 1, wl = (w & 1) * 8;
    const unsigned pcol = (unsigned)(lane >> 3);
    const unsigned ksrc = pcol * (AW * 2) + ((unsigned)((lane & 7) ^ (lane >> 3)) << 4);
    const unsigned vsrc = pcol * (AW * 2) + ((unsigned)(2 * (((lane & 7) >> 1) ^ ((lane >> 4) & 3)) + (lane & 1)) << 4);
    const int kb0 = (wl + li) * 128 + (((0 + g) ^ (li & 7)) << 4), kb1 = (wl + li) * 128 + (((4 + g) ^ (li & 7)) << 4);
    const int q4 = li >> 2, p4 = li & 3, sw = (2 * g + (q4 >> 1)) & 3;
    const int vb = (wl + 4 * g + q4) * 128 + p4 * 8;
    int vo[4];
#pragma unroll
    for (int dt = 0; dt < 4; ++dt) vo[dt] = vb + ((dt ^ sw) << 5);
    const int NU = NBATCH * NH * 2 * (ROWS / 4);
    const int per = (NU + F.G - 1) / F.G;
    const int ub = F.bid * per, u1 = (F.bid + 1) * per < NU ? (F.bid + 1) * per : NU;
#define ATT_RS(r_) ((r_) - 4 < 0 ? 0 : ((r_) - 4 > ROWS - 8 ? ROWS - 8 : (r_) - 4))
#define ATT_STAGE_ROWS(row_lo, nrows) do { const int np_ = 10 * (nrows); for (int pi_ = w; pi_ < np_; pi_ += NWAVES) { const int ri_ = pi_ / 5, pc_ = pi_ - ri_ * 5; const bool isv_ = ri_ >= (nrows); const int row_ = (row_lo) + (isv_ ? ri_ - (nrows) : ri_); \
        __builtin_amdgcn_global_load_lds((const unsigned*)((isv_ ? vg : kg) + (size_t)row_ * (GW * AW * 2) + (size_t)pc_ * 8 * (AW * 2)), (LAS unsigned*)(L + (isv_ ? VOFF : KOFF) + (row_ % NSL) * RSL + pc_ * 1024), 16, 0, 0); } } while (0)
    pg8::bf16x8 qf[2], qn[2];
    qn[0] = qn[1] = (pg8::bf16x8){0, 0, 0, 0, 0, 0, 0, 0};
    int boff[2][4]; int c = 0;
    for (int u = ub; u < u1; ++u) {
        const int bhh = u >> 5, rg = u & 31, ch = bhh & 1, h = (bhh >> 1) & 7, b = bhh >> 4, r0 = rg * 4;
        const bool full = (u == ub) || (rg == 0);
        const bool nsame = (u + 1 < u1) && (((u + 1) & 31) != 0);
        const int cw0 = ch ? 24 : 0;
        const char* kg = (const char*)Kb + ((size_t)(b * SEQ + cw0) * AW + h * HD) * 2 + ksrc;
        const char* vg = (const char*)Vb + ((size_t)(b * SEQ + cw0) * AW + h * HD) * 2 + vsrc;
        const int rlo = ATT_RS(r0), rhi = ATT_RS(r0 + 3) + 7;
        const int r = r0 + ro, rsr = ATT_RS(r);
        if (full) {
            const int qt = 2 * ch + (w & 1), wbg = qt == 0 ? 0 : (qt == 1 ? 8 : (qt == 2 ? 24 : 32));
            c = 16 * qt + li; int cs = c - 8; cs = cs < 0 ? 0 : (cs > GW - 16 ? GW - 16 : cs);
#pragma unroll
            for (int hh = 0; hh < 2; ++hh)
#pragma unroll
                for (int e = 0; e < 4; ++e) { const int kc = wbg + 16 * hh + 4 * g + e; boff[hh][e] = (kc >= cs && kc < cs + 16) ? (kc - c + 15) * 4 : 15 * 31 * 4; }
            __syncthreads();
            ATT_STAGE_ROWS(rlo, rhi - rlo + 1);
            if (F.tid < 15 * 31) { rpbL[F.tid] = rpb[h * 15 * 31 + F.tid] * 1.4426950408889634f; rpbL[15 * 31 + F.tid] = -1e30f; }
            const size_t tq0 = (size_t)b * SEQ + (size_t)r * GW + c;
            qf[0] = *(const pg8::bf16x8*)(Q + tq0 * AW + h * HD + 8 * g); qf[1] = *(const pg8::bf16x8*)(Q + tq0 * AW + h * HD + 32 + 8 * g);
        } else { qf[0] = qn[0]; qf[1] = qn[1]; }
        const size_t tq = (size_t)b * SEQ + (size_t)r * GW + c;
        asm volatile("s_waitcnt vmcnt(0)" ::: "memory");
        __syncthreads();
        if (nsame) { const int nhi = ATT_RS(r0 + 7) + 7;
            if (nhi > rhi) ATT_STAGE_ROWS(rhi + 1, nhi - rhi);
            const size_t tn = tq + 4 * GW;
            qn[0] = *(const pg8::bf16x8*)(Q + tn * AW + h * HD + 8 * g); qn[1] = *(const pg8::bf16x8*)(Q + tn * AW + h * HD + 32 + 8 * g); }
        int sl0 = rsr % NSL;
        f32x4 sacc[8][2];
        float mx = -1e30f;
        int baddr[2][4];
#pragma unroll
        for (int hh = 0; hh < 2; ++hh)
#pragma unroll
            for (int e = 0; e < 4; ++e) baddr[hh][e] = ROFF + boff[hh][e] + (rsr - r + 7) * 124;
#pragma unroll
        for (int i = 0; i < 8; ++i) {
            const int slot = sl0 + i >= NSL ? sl0 + i - NSL : sl0 + i;
#pragma unroll
            for (int hh = 0; hh < 2; ++hh) {
                const pg8::bf16x8 k0 = *(const LAS pg8::bf16x8*)(L + KOFF + slot * RSL + hh * 2048 + kb0), k1 = *(const LAS pg8::bf16x8*)(L + KOFF + slot * RSL + hh * 2048 + kb1);
                f32x4 a = (f32x4){0.f, 0.f, 0.f, 0.f};
                a = __builtin_amdgcn_mfma_f32_16x16x32_bf16(k0, qf[0], a, 0, 0, 0);
                a = __builtin_amdgcn_mfma_f32_16x16x32_bf16(k1, qf[1], a, 0, 0, 0);
#pragma unroll
                for (int e = 0; e < 4; ++e) { a[e] = a[e] * 1.4426950408889634f + *(const LAS float*)(L + baddr[hh][e] + i * 124); mx = fmaxf(mx, a[e]); }
                sacc[i][hh] = a;
            }
        }
        mx = xmax32(xmax16(mx));
        float lsum = 0.f;
#pragma unroll
        for (int i = 0; i < 8; ++i)
#pragma unroll
            for (int hh = 0; hh < 2; ++hh)
#pragma unroll
                for (int e = 0; e < 4; ++e) { const float pv = __builtin_amdgcn_exp2f(sacc[i][hh][e] - mx); sacc[i][hh][e] = pv; lsum += pv; }
        lsum = xadd32(xadd16(lsum));
        f32x4 oacc[4];
#pragma unroll
        for (int dt = 0; dt < 4; ++dt) oacc[dt] = (f32x4){0.f, 0.f, 0.f, 0.f};
#pragma unroll
        for (int i = 0; i < 8; ++i) {
            const int slot = sl0 + i >= NSL ? sl0 + i - NSL : sl0 + i;
            const u32x4 pw = pack8(sacc[i][0], sacc[i][1]);
            const pg8::bf16x8 pf = __builtin_bit_cast(pg8::bf16x8, pw);
#pragma unroll
            for (int dt = 0; dt < 4; ++dt) {
                const s16x4 v0 = vtr(L + VOFF + slot * RSL + vo[dt]), v1 = vtr(L + VOFF + slot * RSL + 2048 + vo[dt]);
                const pg8::bf16x8 vf = (pg8::bf16x8){v0[0], v0[1], v0[2], v0[3], v1[0], v1[1], v1[2], v1[3]};
                oacc[dt] = __builtin_amdgcn_mfma_f32_16x16x32_bf16(vf, pf, oacc[dt], 0, 0, 0);
            }
        }
        const float inv = 1.0f / lsum;
#pragma unroll
        for (int dt = 0; dt < 4; ++dt) { u32x2 o; o.x = pg8::cvt_pk_bf16(oacc[dt][0] * inv, oacc[dt][1] * inv); o.y = pg8::cvt_pk_bf16(oacc[dt][2] * inv, oacc[dt][3] * inv);
            *(u32x2*)(MIX + tq * D + h * HD + 16 * dt + 4 * g) = o; }
    }
#undef ATT_STAGE_ROWS
#undef ATT_RS
    asm volatile("s_waitcnt vmcnt(0)" ::: "memory");
    __syncthreads();
}

__device__ __forceinline__ void f_ln1_router(Frame& F) {
    LAS unsigned char* L = (LAS unsigned char*)F.lds;
    constexpr int WOFF = 0, GBOFF = 72 * 2048, HOFF = GBOFF + 8192;
    const bf16* Z1 = (const bf16*)(F.ws + WS_Z1); fp8* H1F = (fp8*)(F.ws + WS_H1F); const bf16* WRT = (const bf16*)(F.ws + WS_WR_T);
    int* tokE = (int*)(F.ws + WS_TOKE); int* tokPos = (int*)(F.ws + WS_TOKPOS); float* tokW = (float*)(F.ws + WS_TOKW); int* elist = (int*)(F.ws + WS_ELIST);
    unsigned* counts = F.ctl + CW_CNT;
    LAS float* GB = (LAS float*)(L + GBOFF);
    LAS int* hist = (LAS int*)(L + HOFF); LAS int* base = hist + 64; LAS int* lE = base + 64; LAS int* lR = lE + 512; LAS float* lW = (LAS float*)(lR + 512);
    const int lane = F.lane, tk = lane & 15, g = lane >> 4;
    __syncthreads();
    for (int i = F.tid; i < 72 * 128; i += NTHR) { const int n = i >> 7, ch = i & 127; *(LAS u32x4*)(L + WOFF + n * 2048 + ((ch ^ (n & 15)) << 4)) = *(const u32x4*)(WRT + (size_t)n * D + ch * 8); }
    for (int i = F.tid; i < 2048; i += NTHR) GB[i] = i < 1024 ? F.in[I_LN1G][i] : F.in[I_LN1B][i - 1024];
    __syncthreads();
    int brow[5];
#pragma unroll
    for (int t = 0; t < 5; ++t) brow[t] = t < 4 ? 16 * t + tk : 64 + (tk & 7);
    const float be0 = F.in[I_BRE2][tk], be1 = F.in[I_BRE2][16 + tk], be2 = F.in[I_BRE2][32 + tk], be3 = F.in[I_BRE2][48 + tk], bg = F.in[I_BRG][tk & 7];
    for (int chunk = F.bid; chunk < T / 256; chunk += F.G) {
        if (F.tid < 64) hist[F.tid] = 0;
        __syncthreads();
#pragma unroll 1
        for (int grp = 0; grp < 2; ++grp) {
            const int tl0 = F.wave * 32 + grp * 16, t0 = chunk * 256 + tl0;
            const bf16* zp = Z1 + (size_t)(t0 + tk) * D + 8 * g;
            float s1 = 0.f, s2 = 0.f;
            { const f32x2_t* sp = (const f32x2_t*)(F.ws + WS_STATS) + (size_t)(4 * g) * T + (t0 + tk);
#pragma unroll
              for (int j = 0; j < 4; ++j) { const f32x2_t pj = sp[(size_t)j * T]; s1 += pj[0]; s2 += pj[1]; } }
            s1 = xadd32(xadd16(s1)); s2 = xadd32(xadd16(s2));
            const float mean = s1 * (1.0f / D), var = s2 * (1.0f / D) - mean * mean, rstd = rsqrtf(var + LN_EPS);
            if (g == 0) { f32x2_t mr; mr[0] = mean; mr[1] = rstd; ((f32x2_t*)(F.ws + WS_MR))[t0 + tk] = mr; }
            f32x4 acc[5];
#pragma unroll
            for (int t = 0; t < 5; ++t) acc[t] = (f32x4){0.f, 0.f, 0.f, 0.f};
            fp8* hp8 = H1F + (size_t)(t0 + tk) * D + 8 * g;
#define RT_LOAD(dst, blk) do { _Pragma("unroll") for (int i_ = 0; i_ < 4; ++i_) dst[i_] = *(const u32x4*)(zp + 32 * ((blk) * 4 + i_)); } while (0)
#define RT_PROC(src, blk) do { _Pragma("unroll") for (int i_ = 0; i_ < 4; ++i_) { const int sI = (blk) * 4 + i_; const u32x4 f = src[i_]; \
                const int k = 32 * sI + 8 * g; \
                const f32x4 g0 = *(const LAS f32x4*)(GB + k), g1 = *(const LAS f32x4*)(GB + k + 4), b0 = *(const LAS f32x4*)(GB + 1024 + k), b1 = *(const LAS f32x4*)(GB + 1024 + k + 4); \
                f32x4 v0, v1; \
                v0[0] = (__uint_as_float(f[0] << 16) - mean) * rstd * g0[0] + b0[0]; v0[1] = (__uint_as_float(f[0] & 0xffff0000u) - mean) * rstd * g0[1] + b0[1]; \
                v0[2] = (__uint_as_float(f[1] << 16) - mean) * rstd * g0[2] + b0[2]; v0[3] = (__uint_as_float(f[1] & 0xffff0000u) - mean) * rstd * g0[3] + b0[3]; \
                v1[0] = (__uint_as_float(f[2] << 16) - mean) * rstd * g1[0] + b1[0]; v1[1] = (__uint_as_float(f[2] & 0xffff0000u) - mean) * rstd * g1[1] + b1[1]; \
                v1[2] = (__uint_as_float(f[3] << 16) - mean) * rstd * g1[2] + b1[2]; v1[3] = (__uint_as_float(f[3] & 0xffff0000u) - mean) * rstd * g1[3] + b1[3]; \
                const u32x4 hw = pack8(v0, v1); \
                { u32x2 w8; w8.x = pk4_fp8(v0[0], v0[1], v0[2], v0[3]); w8.y = pk4_fp8(v1[0], v1[1], v1[2], v1[3]); *(u32x2*)(hp8 + 32 * sI) = w8; } \
                const pg8::bf16x8 af = __builtin_bit_cast(pg8::bf16x8, hw); \
                const int ch = 4 * sI + g; \
                _Pragma("unroll") for (int t = 0; t < 5; ++t) { const pg8::bf16x8 bfr = *(const LAS pg8::bf16x8*)(L + WOFF + brow[t] * 2048 + ((ch ^ (brow[t] & 15)) << 4)); \
                    acc[t] = __builtin_amdgcn_mfma_f32_16x16x32_bf16(af, bfr, acc[t], 0, 0, 0); } } } while (0)
            { u32x4 fa[4], fb[4];
              RT_LOAD(fa, 0);
#pragma unroll 1
              for (int blk = 0; blk < 8; blk += 2) {
                  RT_LOAD(fb, blk + 1);
                  RT_PROC(fa, blk);
                  if (blk + 2 < 8) RT_LOAD(fa, blk + 2);
                  RT_PROC(fb, blk + 1);
              } }
#undef RT_LOAD
#undef RT_PROC
#pragma unroll
            for (int r = 0; r < 4; ++r) {
                float gv = acc[4][r] + bg; int gi = tk & 7;
                const float gown = gv;
#pragma unroll
                for (int m = 1; m < 8; m <<= 1) { const float ov = __shfl_xor(gv, m); const int oi = __shfl_xor(gi, m); const bool take = ov > gv || (ov == gv && oi < gi); gv = take ? ov : gv; gi = take ? oi : gi; }
                float ge = __expf(gown - gv);
#pragma unroll
                for (int m = 1; m < 8; m <<= 1) ge += __shfl_xor(ge, m);
                const float gval = 1.0f / ge;
                const int tsel = gi >> 1;
                float ev = tsel == 0 ? acc[0][r] + be0 : (tsel == 1 ? acc[1][r] + be1 : (tsel == 2 ? acc[2][r] + be2 : acc[3][r] + be3));
                if ((tk >> 3) != (gi & 1)) ev = -3e38f;
                float v1 = ev; int i1 = tk & 7;
#pragma unroll
                for (int m = 1; m < 16; m <<= 1) { const float ov = __shfl_xor(v1, m); const int oi = __shfl_xor(i1, m); const bool take = ov > v1 || (ov == v1 && oi < i1); v1 = take ? ov : v1; i1 = take ? oi : i1; }
                float ev2 = ((tk & 7) == i1) ? -3e38f : ev; float v2 = ev2; int i2 = tk & 7;
#pragma unroll
                for (int m = 1; m < 16; m <<= 1) { const float ov = __shfl_xor(v2, m); const int oi = __shfl_xor(i2, m); const bool take = ov > v2 || (ov == v2 && oi < i2); v2 = take ? ov : v2; i2 = take ? oi : i2; }
                if (tk == 0) {
                    const float ex = __expf(v2 - v1), w0 = gval / (1.0f + ex), w1 = gval * ex / (1.0f + ex);
                    const int tl = tl0 + 4 * g + r, E0 = gi * EPG + i1, E1 = gi * EPG + i2;
                    lE[2 * tl] = E0; lE[2 * tl + 1] = E1; lW[2 * tl] = w0; lW[2 * tl + 1] = w1;
                    lR[2 * tl] = atomicAdd((int*)&hist[E0], 1); lR[2 * tl + 1] = atomicAdd((int*)&hist[E1], 1);
                }
            }
        }
        __syncthreads();
        if (F.tid < 64) base[F.tid] = (int)__hip_atomic_fetch_add(&counts[F.tid], (unsigned)hist[F.tid], __ATOMIC_RELAXED, __HIP_MEMORY_SCOPE_AGENT);
        __syncthreads();
        { const int a = F.tid, ga = chunk * 512 + a; const int e = lE[a], pos = base[e] + lR[a]; tokE[ga] = e; tokPos[ga] = pos; tokW[ga] = lW[a]; elist[(size_t)e * ECAP + pos] = ga >> 1; }
        __syncthreads();
    }
}

__device__ __forceinline__ void f_proj(Frame& F) {
    DenseSched S{(unsigned)WS_XB, (unsigned)WS_WIN_T, T / 256, INW / 256, F.G, F.bid, 256u * D * 2, 256u * D * 2, 1 << 30, 0};
    EpiProj E{(bf16*)(F.ws + WS_Q), (bf16*)(F.ws + WS_UA)};
    static_assert(WS_V - WS_K == WS_K - WS_Q, "Q|K|V spacing");
    pg8::gemm_phase<EpiProj, DenseSched, false, false, ENG_SP2>((LAS unsigned char*)F.lds, F.ws, D * 2, D * 2, D / 64, S, E);
}
__device__ __forceinline__ void f_glu(Frame& F) {
    DenseSched S{(unsigned)WS_G, (unsigned)WS_WGLU_T, T / 256, SW / 256, F.G, F.bid, 256u * SW * 2, 256u * SW * 2, 1 << 30, 0};
    EpiGlu E{(const bf16*)(F.ws + WS_G), (bf16*)(F.ws + WS_MIX), F.in[I_BGLU]};
    pg8::gemm_phase<EpiGlu, DenseSched, false, false, ENG_SP2>((LAS unsigned char*)F.lds, F.ws, SW * 2, SW * 2, SW / 64, S, E);
}
__device__ __forceinline__ void f_wout(Frame& F) {
    DenseSched S{(unsigned)WS_MIX, (unsigned)WS_WOUT_T, T / 256, D / 256, F.G, F.bid, 256u * D * 2, 256u * D * 2, 1 << 30, 0};
    EpiWout E{(bf16*)(F.ws + WS_Z1), (f32x2_t*)(F.ws + WS_STATS)};
    static_assert(WS_Z1 == WS_XB, "Z1 overlays XB");
    pg8::gemm_phase<EpiWout, DenseSched, false, false, ENG_SP2>((LAS unsigned char*)F.lds, F.ws, D * 2, D * 2, D / 64, S, E);
}
__device__ __forceinline__ void f_gateup(Frame& F) {
    int* pb = (int*)(F.lds + pg8::STAGE_BYTES);
    load_pbase(F, pb);
    MoeSched S{(unsigned)WS_H1F, (unsigned)WS_WGU_T, (const int*)(F.ws + WS_ELIST), pb, pb[64] / 256, 4, F.G, F.bid, 0u, 256u * D, 1024u * D, (unsigned)WS_ELIST};
    EpiGateUp E{(fp8*)(F.ws + WS_HID)};
    pg8::gemm_phase<EpiGateUp, MoeSched, true, true>((LAS unsigned char*)F.lds, F.ws, D, D, D / 128, S, E);
}
__device__ __forceinline__ void f_down(Frame& F) {
    int* pb = (int*)(F.lds + pg8::STAGE_BYTES);
    load_pbase(F, pb);
    MoeSched S{(unsigned)WS_HID, (unsigned)WS_WDN_T, nullptr, pb, pb[64] / 256, 4, F.G, F.bid, 256u * DE, 256u * DE, (unsigned)D * DE, 0u};
    EpiDown E{(fp8*)(F.ws + WS_O)};
    pg8::gemm_phase<EpiDown, MoeSched, false, true>((LAS unsigned char*)F.lds, F.ws, DE, DE, DE / 128, S, E);
}

__device__ __forceinline__ void mkframe(Frame& F, const Args& args, unsigned char* l) {
    F.lds = l; F.ws = args.ws; F.ctl = (unsigned*)(args.ws + WS_CTL);
    F.tid = threadIdx.x; F.lane = F.tid & 63; F.wave = __builtin_amdgcn_readfirstlane(F.tid >> 6); F.G = gridDim.x; F.bid = blockIdx.x;
    F.in = args.in; F.out = args.out;
}
constexpr int NPHASE = 11;
__global__ void __launch_bounds__(NTHR, 2) fwd(Args args) {
    extern __shared__ __attribute__((aligned(16))) unsigned char lds[];
    Frame F; mkframe(F, args, lds);
    volatile LAS unsigned* misc = (volatile LAS unsigned*)((LAS unsigned char*)lds + LDS_BYTES - 64);
    if (F.tid < 16) misc[F.tid] = 0u;
    __syncthreads();
    const int lo = args.ph_lo, hi = args.ph_hi;
    XcdBarrier bar; bar.bar = F.ctl + CW_BAR; bar.x = 0; bar.st = misc;
    if (hi - lo > 1) bar = xcd_barrier_post(F.ctl + CW_BAR, misc);
#define IN(k) (lo <= (k) && (k) < hi)
#define SEAM(k) do { if (IN(k) && IN((k) + 1)) xcd_barrier(bar); } while (0)
#define SEAMF(k) do { if (IN(k) && IN((k) + 1)) xcd_barrier_fill(bar, F); } while (0)
#define RUNP(k, body) do { if (IN(k)) { body; } } while (0)
    RUNP(0, { if (F.bid < SG * 4 || F.G < 256) p0_s5tables(F);
              p0_prologue(F); }); SEAMF(0);
    RUNP(1, f_proj(F)); SEAMF(1);
    RUNP(2, { f_attn(F); f_s5e(F); }); SEAMF(2);
    if (F.G < T / 256) { RUNP(3, f_s5scan(F)); SEAM(3); }
    if (F.G < T / 256) { RUNP(4, f_s5y(F)); SEAMF(4); }
    RUNP(5, f_glu(F)); SEAMF(5);
    RUNP(6, f_wout(F)); SEAMF(6);
    if (IN(7)) { f_ln1_router(F); moe_drain(F); }
    if (IN(7) && IN(9)) xcd_barrier(bar);
    RUNP(9, f_gateup(F)); SEAM(9);
    RUNP(10, f_down(F)); SEAM(10);
    RUNP(11, p_final(F));
#undef RUNP
#undef IN
#undef SEAM
#undef SEAMF
}

extern "C" void kernel_launch(void* const* d_in, const int* in_sizes, int n_in, void* d_out, int out_size, void* d_ws, size_t ws_size, hipStream_t stream) {
    static int grid = 0;
    if (grid == 0) {
        if (n_in != 25 || out_size != T * D || ws_size < WS_END) { fprintf(stderr, "kernel_launch: unexpected shapes n_in %d out %d ws %zu\n", n_in, out_size, ws_size); grid = -1; return; }
        int dev = 0, cus = 0;
        if (hipGetDevice(&dev) != hipSuccess || hipDeviceGetAttribute(&cus, hipDeviceAttributeMultiprocessorCount, dev) != hipSuccess) { grid = -1; return; }
        if (hipFuncSetAttribute((const void*)fwd, hipFuncAttributeMaxDynamicSharedMemorySize, LDS_BYTES) != hipSuccess) { fprintf(stderr, "kernel_launch: hipFuncSetAttribute failed\n"); grid = -1; return; }
        int per_cu = 0;
        if (hipOccupancyMaxActiveBlocksPerMultiprocessor(&per_cu, (const void*)fwd, NTHR, LDS_BYTES) != hipSuccess || per_cu < 1) fprintf(stderr, "kernel_launch: occupancy query says %d\n", per_cu);
        (void)hipGetLastError();
        grid = cus;
    }
    if (grid < 0) return;
    (void)hipMemsetAsync((char*)d_ws + WS_CTL, 0, CTL_ZERO_BYTES, stream);
    Args a{};
    for (int i = 0; i < 25; ++i) a.in[i] = (const float*)d_in[i];
    a.out = (float*)d_out; a.ws = (unsigned char*)d_ws;
#define LAUNCH_FAST(lo_, hi_) do { a.ph_lo = lo_; a.ph_hi = hi_; a.li = lo_; a.pad = 0; hipLaunchKernelGGL(fwd, dim3(grid), dim3(NTHR), LDS_BYTES, stream, a); } while (0)
#ifdef MK_PER_PHASE
    for (int p = 0; p < 12; ++p) LAUNCH_FAST(p, p + 1);
#else
    LAUNCH_FAST(0, 12);
#endif
}
```

```cpp
#include <hip/hip_runtime.h>
#include <cstdio>
#include <cstdint>

#define GAS __attribute__((address_space(1)))
#define LAS __attribute__((address_space(3)))
typedef unsigned short bf16;
typedef float f32x4 __attribute__((ext_vector_type(4)));
typedef unsigned u32x4 __attribute__((ext_vector_type(4)));
typedef unsigned u32x2 __attribute__((ext_vector_type(2)));
typedef short s16x4 __attribute__((ext_vector_type(4)));
typedef int v8i __attribute__((ext_vector_type(8)));
typedef float f32x2_t __attribute__((ext_vector_type(2)));
typedef unsigned char fp8;

constexpr int D = 1024, NBATCH = 8, SEQ = 8192, T = NBATCH * SEQ, GW = 64, ROWS = SEQ / GW, NH = 8, HD = 64, AW = 512, SW = 512;
constexpr int SG = 32, SC = 16, SP = 64, INW = 2048, NEG = 8, EPG = 8, NE = 64, DE = 512;
constexpr int TB = 32;
constexpr int NBLK = T / TB;
constexpr int UAW = TB * SC + 4 * SP;
constexpr float LN_EPS = 1e-5f;
constexpr float ALPHA = 1.189207115002721f;
constexpr int MAXTILES = (2 * T + NE * 255) / 256 + 1;
constexpr int NWAVES = 8, NTHR = 512;
constexpr int ECAP = 2 * T;

constexpr size_t MiB = 1u << 20;
constexpr size_t WS_CTL = 0, CTL_ZERO_BYTES = 32 * 1024;
constexpr size_t WS_TOKE = 1 * MiB, WS_TOKPOS = WS_TOKE + 512 * 1024, WS_TOKW = 2 * MiB;
constexpr size_t WS_S5TAB = 5 * MiB;
constexpr size_t WS_WIN_T = 8 * MiB, WS_WGLU_T = 12 * MiB, WS_WR_T = 12 * MiB + 512 * 1024, WS_WOUT_T = 13 * MiB;
constexpr size_t WS_KY = 16 * MiB, WS_WE = 40 * MiB, WS_WGU_T = 48 * MiB, WS_WDN_T = 176 * MiB;
constexpr int MIXW = 1536;
constexpr size_t WS_XB = 240 * MiB, WS_Z1 = 240 * MiB;
constexpr size_t WS_WIN8_T = WS_WIN_T + 1 * MiB  , WS_XB8 = 784 * MiB  ;
constexpr size_t WS_Q = 368 * MiB, WS_K = 432 * MiB, WS_V = 496 * MiB, WS_UA = 560 * MiB, WS_E = 656 * MiB, WS_G = 720 * MiB, WS_MIX = 784 * MiB, WS_H1 = 784 * MiB;
constexpr size_t WS_HID = 784 * MiB  , WS_O = 384 * MiB, WS_H1F = 912 * MiB  , WS_ELIST = 976 * MiB  , WS_STATS = 1008 * MiB  , WS_MR = 1016 * MiB  , WS_END = 1017 * MiB;
static_assert((4096 + 3456) * 4 <= 32 * 1024, "control words inside the memset region");
constexpr int CW_TMO = 0, CW_XQ = 512  , CW_MQ = 576  , CW_CNT = 1024  , CW_BAR = 4096;

constexpr int LDS_BYTES = 163840;

__device__ __forceinline__ float bf2f(bf16 b) { return __uint_as_float(((unsigned)b) << 16); }
__device__ __forceinline__ bf16 f2bf(float f) { unsigned u = __float_as_uint(f); return (bf16)((u + 0x7fffu + ((u >> 16) & 1u)) >> 16); }
__device__ __forceinline__ unsigned pk2(float lo, float hi) { return (unsigned)f2bf(lo) | ((unsigned)f2bf(hi) << 16); }
__device__ __forceinline__ unsigned pk4_fp8(float a, float b, float c, float d) { int w = 0; w = __builtin_amdgcn_cvt_pk_fp8_f32(a, b, w, false); w = __builtin_amdgcn_cvt_pk_fp8_f32(c, d, w, true); return (unsigned)w; }
__device__ __forceinline__ float xadd16(float x) { const unsigned b = __float_as_uint(x); const auto r = __builtin_amdgcn_permlane16_swap(b, b, false, false); return __uint_as_float(r[0]) + __uint_as_float(r[1]); }
__device__ __forceinline__ float xadd32(float x) { const unsigned b = __float_as_uint(x); const auto r = __builtin_amdgcn_permlane32_swap(b, b, false, false); return __uint_as_float(r[0]) + __uint_as_float(r[1]); }
__device__ __forceinline__ float xmax16(float x) { const unsigned b = __float_as_uint(x); const auto r = __builtin_amdgcn_permlane16_swap(b, b, false, false); return fmaxf(__uint_as_float(r[0]), __uint_as_float(r[1])); }
__device__ __forceinline__ float xmax32(float x) { const unsigned b = __float_as_uint(x); const auto r = __builtin_amdgcn_permlane32_swap(b, b, false, false); return fmaxf(__uint_as_float(r[0]), __uint_as_float(r[1])); }
__device__ __forceinline__ float wave_sum(float v) {
#pragma unroll
    for (int o = 1; o < 64; o <<= 1) v += __shfl_xor(v, o);
    return v;
}
__device__ __forceinline__ float sigmoidf_(float x) { return __builtin_amdgcn_rcpf(1.0f + __builtin_amdgcn_exp2f(-1.4426950408889634f * x)); }
__device__ __forceinline__ float gelu_tanh(float x) { const float z = 0.7978845608028654f * (x + 0.044715f * x * x * x); return x * sigmoidf_(2.0f * z); }

#define XB_TMO      128
#define XB_XCNT(j)  (256  + 64 * (j))
#define XB_XSUB(j)  (1280 + 64 * (j))
#define XB_XGEN(j)  (2304 + 64 * (j))
#define XB_TOP      3328
#define XB_TOPGEN   3392
#define XCD_BAR_WORDS 3456
#define XB_SPIN_CAP (1u << 18)
__device__ __forceinline__ unsigned xb_ld(unsigned* p)              { return __hip_atomic_load(p, __ATOMIC_RELAXED, __HIP_MEMORY_SCOPE_AGENT); }
__device__ __forceinline__ unsigned xb_add(unsigned* p, unsigned v) { return __hip_atomic_fetch_add(p, v, __ATOMIC_RELAXED, __HIP_MEMORY_SCOPE_AGENT); }
__device__ __forceinline__ unsigned xb_xcc_id() { return (unsigned)__builtin_amdgcn_s_getreg((3 << 11) | 20) & 0xFu; }
#define XB_SPIN(cond, bar) do { unsigned _sp = 0; while (cond) { __builtin_amdgcn_s_sleep(1); \
    if ((++_sp & 255u) == 0u) { if (xb_ld(&(bar)[XB_TMO])) break; if (_sp > XB_SPIN_CAP) { atomicAdd(&(bar)[XB_TMO], 1u); break; } } } } while (0)
struct XcdBarrier { unsigned* bar; unsigned x; volatile LAS unsigned* st; };
__device__ __forceinline__ XcdBarrier xcd_barrier_post(unsigned* bar, volatile LAS unsigned* st) {
    XcdBarrier b; b.bar = bar; b.x = xb_xcc_id(); b.st = st;
    if (threadIdx.x == 0) (void)xb_add(&bar[XB_XCNT(b.x)], 1u);
    return b;
}
__device__ __forceinline__ void xcd_barrier_complete(unsigned* bar, unsigned x, unsigned& nloc, unsigned& nx) {
    const unsigned G = gridDim.x * gridDim.y * gridDim.z;
    unsigned sum, cnt, mine, sp = 0u;
    for (;;) {
        sum = 0u; cnt = 0u; mine = 0u;
#pragma unroll
        for (unsigned j = 0; j < 16; ++j) { const unsigned c = xb_ld(&bar[XB_XCNT(j)]); sum += c; cnt += (c > 0u) ? 1u : 0u; mine = (j == x) ? c : mine; }
        if (sum == G) break;
        __builtin_amdgcn_s_sleep(1);
        if ((++sp & 255u) == 0u) { if (xb_ld(&bar[XB_TMO])) break; if (sp > XB_SPIN_CAP) { atomicAdd(&bar[XB_TMO], 1u); break; } }
    }
    nloc = mine > 0u ? mine : 1u; nx = cnt > 0u ? cnt : 1u;
}
__device__ __forceinline__ void xcd_barrier(const XcdBarrier& b) {
    asm volatile("s_waitcnt vmcnt(0)" ::: "memory");
    __syncthreads();
    if (threadIdx.x == 0) {
        unsigned* bar = b.bar;
        __builtin_amdgcn_s_waitcnt(0);
        unsigned nloc = b.st[0], nx = b.st[1];
        if (nloc == 0u) { xcd_barrier_complete(bar, b.x, nloc, nx); b.st[0] = nloc; b.st[1] = nx; }
        const unsigned old = xb_add(&bar[XB_XSUB(b.x)], 1u);
        const unsigned gen = old / nloc;
        if (old + 1u == (gen + 1u) * nloc) {
            __builtin_amdgcn_fence(__ATOMIC_RELEASE, "agent");
            asm volatile("s_waitcnt vmcnt(0)" ::: "memory");
            const unsigned og = xb_add(&bar[XB_TOP], 1u);
            const unsigned tg = og / nx;
            if (og + 1u == (tg + 1u) * nx) xb_add(&bar[XB_TOPGEN], 1u);
            else XB_SPIN(xb_ld(&bar[XB_TOPGEN]) == tg, bar);
            __builtin_amdgcn_fence(__ATOMIC_ACQUIRE, "agent");
            xb_add(&bar[XB_XGEN(b.x)], 1u);
            asm volatile("s_waitcnt vmcnt(0)" ::: "memory");
        } else {
            XB_SPIN(xb_ld(&bar[XB_XGEN(b.x)]) == gen, bar);
            __builtin_amdgcn_fence(__ATOMIC_ACQUIRE, "agent");
            asm volatile("s_waitcnt vmcnt(0)" ::: "memory");
        }
    }
    __syncthreads();
}

struct Args { const float* in[25]; float* out; unsigned char* ws; int ph_lo, ph_hi, li, pad; };
struct Frame {
    unsigned char* lds;
    unsigned char* ws; unsigned* ctl;
    int tid, lane, wave, G, bid;
    const float* const* in; float* out;
};
enum { I_X = 0, I_WIN, I_RPB, I_ARE, I_AIM, I_LDT, I_BRE, I_BIM, I_CRE, I_CIM, I_SD, I_WGLU, I_BGLU, I_WOUT, I_LN1G, I_LN1B, I_WRG, I_BRG, I_WRE, I_BRE2, I_WGATE, I_WUP, I_WDOWN, I_LN2G, I_LN2B };

__device__ __forceinline__ void load_pbase(Frame& F, int* pb) {
    if (F.tid < 64) { const int e = F.tid;
        const int c = (int)__hip_atomic_load(&F.ctl[CW_CNT + e], __ATOMIC_RELAXED, __HIP_MEMORY_SCOPE_AGENT);
        const int padded = (c + 255) / 256 * 256; int incl = padded;
#pragma unroll
        for (int o = 1; o < 64; o <<= 1) { const int v = __shfl_up(incl, o); incl += (e >= o) ? v : 0; }
        const int excl = incl - padded;
        pb[e] = excl; pb[66 + e] = c; if (e == NE - 1) pb[64] = incl;
        for (int t = excl >> 8; t < (incl >> 8); ++t) pb[132 + t] = e; }
    __syncthreads();
}
__device__ __forceinline__ float fp8_to_f32(unsigned w, int sel) { return sel == 0 ? __builtin_amdgcn_cvt_f32_fp8((int)w, 0) : (sel == 1 ? __builtin_amdgcn_cvt_f32_fp8((int)w, 1) : (sel == 2 ? __builtin_amdgcn_cvt_f32_fp8((int)w, 2) : __builtin_amdgcn_cvt_f32_fp8((int)w, 3))); }
__device__ __forceinline__ void p_final(Frame& F) {
    int* pb = (int*)F.lds;
    load_pbase(F, pb);
    const int* tokE = (const int*)(F.ws + WS_TOKE); const int* tokPos = (const int*)(F.ws + WS_TOKPOS);
    const bf16* Z1 = (const bf16*)(F.ws + WS_Z1); const fp8* O = (const fp8*)(F.ws + WS_O); const f32x2_t* MR = (const f32x2_t*)(F.ws + WS_MR);
    const float* tokW = (const float*)(F.ws + WS_TOKW);
    const float* g1 = F.in[I_LN1G]; const float* b1 = F.in[I_LN1B]; const float* g2 = F.in[I_LN2G]; const float* b2 = F.in[I_LN2B];
    const int lane = F.lane;
    constexpr int NT4 = 4;
    for (int tb = (F.bid * NWAVES + F.wave) * NT4; tb < T; tb += F.G * NWAVES * NT4) {
        u32x2 h[NT4][4]; unsigned a[NT4][4], b[NT4][4]; float w0[NT4], w1[NT4], mean1[NT4], rstd1[NT4];
#pragma unroll
        for (int q = 0; q < NT4; ++q) { const int t = tb + q; const int s0 = pb[tokE[2 * t]] + tokPos[2 * t], s1 = pb[tokE[2 * t + 1]] + tokPos[2 * t + 1]; w0[q] = tokW[2 * t] * 0.125f; w1[q] = tokW[2 * t + 1] * 0.125f;
            { const f32x2_t mr = MR[t]; mean1[q] = mr[0]; rstd1[q] = mr[1]; }
#pragma unroll
            for (int j = 0; j < 4; ++j) { const int c = 256 * j + lane * 4; h[q][j] = __builtin_nontemporal_load((const u32x2*)(Z1 + (size_t)t * D + c)); a[q][j] = __builtin_nontemporal_load((const unsigned*)(O + (size_t)s0 * D + c)); b[q][j] = __builtin_nontemporal_load((const unsigned*)(O + (size_t)s1 * D + c)); } }
#pragma unroll
        for (int q = 0; q < NT4; ++q) { const int t = tb + q;
            float v[16];
#pragma unroll
            for (int j = 0; j < 4; ++j) {
                const int c = 256 * j + lane * 4; const f32x4 gg = *(const f32x4*)(g1 + c), bb = *(const f32x4*)(b1 + c);
                const float z0 = __uint_as_float(h[q][j].x << 16), z1 = __uint_as_float(h[q][j].x & 0xffff0000u), z2 = __uint_as_float(h[q][j].y << 16), z3 = __uint_as_float(h[q][j].y & 0xffff0000u);
                v[4 * j + 0] = ALPHA * ((z0 - mean1[q]) * rstd1[q] * gg[0] + bb[0]) + (w0[q] * fp8_to_f32(a[q][j], 0) + w1[q] * fp8_to_f32(b[q][j], 0));
                v[4 * j + 1] = ALPHA * ((z1 - mean1[q]) * rstd1[q] * gg[1] + bb[1]) + (w0[q] * fp8_to_f32(a[q][j], 1) + w1[q] * fp8_to_f32(b[q][j], 1));
                v[4 * j + 2] = ALPHA * ((z2 - mean1[q]) * rstd1[q] * gg[2] + bb[2]) + (w0[q] * fp8_to_f32(a[q][j], 2) + w1[q] * fp8_to_f32(b[q][j], 2));
                v[4 * j + 3] = ALPHA * ((z3 - mean1[q]) * rstd1[q] * gg[3] + bb[3]) + (w0[q] * fp8_to_f32(a[q][j], 3) + w1[q] * fp8_to_f32(b[q][j], 3));
            }
            float s = 0.f;
#pragma unroll
            for (int j = 0; j < 16; ++j) s += v[j];
            const float mean = wave_sum(s) * (1.0f / D);
            float qv = 0.f;
#pragma unroll
            for (int j = 0; j < 16; ++j) { v[j] -= mean; qv += v[j] * v[j]; }
            const float rstd = rsqrtf(wave_sum(qv) * (1.0f / D) + LN_EPS);
#pragma unroll
            for (int j = 0; j < 4; ++j) {
                const int c = 256 * j + lane * 4; const f32x4 gg = *(const f32x4*)(g2 + c), bb = *(const f32x4*)(b2 + c);
                f32x4 o;
#pragma unroll
                for (int e = 0; e < 4; ++e) o[e] = v[4 * j + e] * rstd * gg[e] + bb[e];
                __builtin_nontemporal_store(o, (f32x4*)(F.out + (size_t)t * D + c));
            }
        }
    }
}

#ifndef ENG_SP2
#define ENG_SP2 true
#endif
namespace pg8 {
typedef short bf16x8 __attribute__((ext_vector_type(8)));
constexpr int BM = 256, BK = 64, HALF = 128, HTB = HALF * BK * 2, STAGE_BYTES = 8 * HTB, NXCD = 8, WGM = 8;
__host__ __device__ __forceinline__ int lds_byte(int r, int c) { const int st = (r >> 4) * 2 + (c >> 5), rr = r & 15, cc = c & 31, ob = rr * 64 + cc * 2; return st * 1024 + (ob ^ (((ob >> 9) & 1) << 5)); }
__host__ __device__ __forceinline__ void stage_rc(int b, int& R, int& C) { const int st = b / 1024, sb = b % 1024, swz = sb ^ (((sb >> 9) & 1) << 5); R = (st >> 1) * 16 + swz / 64; C = (st & 1) * 32 + (swz % 64) / 2; }
__host__ __device__ __forceinline__ int perm128(int rho) { return 64 * (rho >> 5) + 16 * ((rho & 15) >> 2) + 4 * ((rho >> 4) & 1) + (rho & 3); }
__host__ __device__ __forceinline__ int perm32(int rho) { const int n = rho >> 4, i = rho & 15; return 8 * (i >> 2) + 4 * n + (i & 3); }
__device__ __forceinline__ unsigned cvt_pk_bf16(float lo, float hi) { unsigned r; asm volatile("v_cvt_pk_bf16_f32 %0, %1, %2" : "=v"(r) : "v"(lo), "v"(hi)); return r; }

struct Unit { int pm, pn, aux; unsigned A, B; const int* rows; unsigned rows_off; int nvalid; };
typedef int i32x4 __attribute__((ext_vector_type(4)));
template <bool F8> struct Frag { bf16x8 kh[2]; };
template <> struct Frag<true> { v8i v; };
__device__ __forceinline__ void frag_set8(Frag<true>& f, i32x4 lo, i32x4 hi) { f.v = __builtin_shufflevector(lo, hi, 0, 1, 2, 3, 4, 5, 6, 7); }
__device__ __forceinline__ void frag_set8(Frag<false>& f, i32x4 lo, i32x4 hi) { f.kh[0] = __builtin_bit_cast(bf16x8, lo); f.kh[1] = __builtin_bit_cast(bf16x8, hi); }
__device__ __forceinline__ v8i frag_v8(const Frag<true>& f) { return f.v; }
__device__ __forceinline__ bf16x8 frag_lo(const Frag<false>& f) { return f.kh[0]; }
__device__ __forceinline__ bf16x8 frag_hi(const Frag<false>& f) { return f.kh[1]; }
__device__ __forceinline__ bf16x8 frag_lo(const Frag<true>& f) { return __builtin_bit_cast(bf16x8, (i32x4)__builtin_shufflevector(f.v, f.v, 0, 1, 2, 3)); }
__device__ __forceinline__ bf16x8 frag_hi(const Frag<true>& f) { return __builtin_bit_cast(bf16x8, (i32x4)__builtin_shufflevector(f.v, f.v, 4, 5, 6, 7)); }
__device__ __forceinline__ v8i frag_v8(const Frag<false>& f) { return __builtin_shufflevector(__builtin_bit_cast(i32x4, f.kh[0]), __builtin_bit_cast(i32x4, f.kh[1]), 0, 1, 2, 3, 4, 5, 6, 7); }
__device__ __forceinline__ void tile_of(int L, int nM, int nN, int& pm, int& pn) {
    const int nwg = nM * nN; int wgid = L;
    { const int q = nwg / NXCD, r = nwg % NXCD, xcd = wgid % NXCD, off = wgid / NXCD; wgid = (xcd < r ? xcd * (q + 1) : r * (q + 1) + (xcd - r) * q) + off; }
    const int nig = WGM * nN, gid = wgid / nig, fm = gid * WGM, gsz = (nM - fm) < WGM ? (nM - fm) : WGM;
    pm = fm + ((wgid % nig) % gsz); pn = (wgid % nig) / gsz;
}

template <class Epi, class Sched, bool GATHER, bool F8 = false, bool SP2 = true, int MIXK = 0>
__device__ __forceinline__ void gemm_phase(LAS unsigned char* lds, const unsigned char* wsbase, const int lda, const int ldb, const int nt, const Sched& S, const Epi& E) {
    const __amdgpu_buffer_rsrc_t rsrc = __builtin_amdgcn_make_buffer_rsrc((void*)wsbase, 0, 0x7fffffff, 0x00020000);
    int tid_ = threadIdx.x; asm volatile("" : "+v"(tid_));
    const int tid = tid_, wid = __builtin_amdgcn_readfirstlane(tid >> 6), lane = tid & 63, wr = wid >> 2, wc = wid & 3, fr = lane & 15, fq = lane >> 4;
    unsigned voffA[2], voffB[2];
#pragma unroll
    for (int i = 0; i < 2; ++i) { int R, C; stage_rc(tid * 16 + i * 8192, R, C); const int Rb = Epi::PERM2 ? perm128(R) : (Epi::PERM ? ((R & ~31) + perm32(R & 31)) : R);
        voffA[i] = (unsigned)(R * lda + C * 2); voffB[i] = (unsigned)(Rb * ldb + C * 2); }
    const unsigned kstep = (unsigned)(BK * 2);
    const unsigned hstepA = (unsigned)(HALF * lda), hstepB = (unsigned)((Epi::PERM2 ? 8 : HALF) * ldb);
    const unsigned ldsw = (unsigned)wid * 1024u;
    const int aoff = F8 ? lds_byte(wr * 64 + fr, fq * 16) : lds_byte(wr * 64 + fr, fq * 8), boff = F8 ? lds_byte(wc * 32 + fr, fq * 16) : lds_byte(wc * 32 + fr, fq * 8);

    LAS unsigned char* const ldsA = lds + aoff; LAS unsigned char* const ldsB = lds + 4 * HTB + boff;
    LAS unsigned char* const ldsA8 = MIXK > 0 ? lds + lds_byte(wr * 64 + fr, fq * 16) : ldsA; LAS unsigned char* const ldsB8 = MIXK > 0 ? lds + 4 * HTB + lds_byte(wc * 32 + fr, fq * 16) : ldsB;
#define PG8_BA(f8_) ((MIXK > 0 && (f8_)) ? ldsA8 : ldsA)
#define PG8_BB(f8_) ((MIXK > 0 && (f8_)) ? ldsB8 : ldsB)
#define PG8_SA(b, h) (((b) * 2 + (h)) * HTB)
#define PG8_SB(b, h) ((4 + (b) * 2 + (h)) * HTB)
#define PG8_STAGE(bufoff, gbase, voff) do { _Pragma("unroll") for (int _i = 0; _i < 2; ++_i) \
        __builtin_amdgcn_raw_ptr_buffer_load_lds(rsrc, (LAS unsigned*)(lds + (bufoff) + ldsw + _i * 8192), 16, (int)(voff)[_i], (int)(gbase), 0, 0); } while (0)
#define PG8_STAGE_A(b, h, base, vg) do { if constexpr (GATHER) { PG8_STAGE(PG8_SA(b, h), base, (vg)[h]); } else { PG8_STAGE(PG8_SA(b, h), (base) + (h) * hstepA, voffA); } } while (0)
#define PG8_RD16(base, off) (*(const LAS i32x4*)((base) + (off)))
#define PG8_LDA_(f8_, dst, b, h) do { _Pragma("unroll") for (int m = 0; m < 4; ++m) { if constexpr (f8_) { const i32x4 lo_ = PG8_RD16(PG8_BA(f8_), PG8_SA(b, h) + m * 2048), hi_ = PG8_RD16(PG8_BA(f8_), PG8_SA(b, h) + m * 2048 + 16); frag_set8(dst[m], lo_, hi_); } \
        else { const i32x4 lo_ = PG8_RD16(ldsA, PG8_SA(b, h) + m * 2048), hi_ = PG8_RD16(ldsA, PG8_SA(b, h) + m * 2048 + 1024); frag_set8(dst[m], lo_, hi_); } } } while (0)
#define PG8_LDB_(f8_, dst, b, h) do { _Pragma("unroll") for (int n = 0; n < 2; ++n) { if constexpr (f8_) { const i32x4 lo_ = PG8_RD16(PG8_BB(f8_), ((b) * 2 + (h)) * HTB + n * 2048), hi_ = PG8_RD16(PG8_BB(f8_), ((b) * 2 + (h)) * HTB + n * 2048 + 16); frag_set8(dst[n], lo_, hi_); } \
        else { const i32x4 lo_ = PG8_RD16(ldsB, ((b) * 2 + (h)) * HTB + n * 2048), hi_ = PG8_RD16(ldsB, ((b) * 2 + (h)) * HTB + n * 2048 + 1024); frag_set8(dst[n], lo_, hi_); } } } while (0)
#define PG8_MMA_(f8_, ai, bj, At, Bt) do { __builtin_amdgcn_s_setprio(1); \
        if constexpr (f8_) { _Pragma("unroll") for (int m = 0; m < 4; ++m) _Pragma("unroll") for (int n = 0; n < 2; ++n) \
            acc[ai][bj][m][n] = __builtin_amdgcn_mfma_scale_f32_16x16x128_f8f6f4(frag_v8(Bt[n]), frag_v8(At[m]), acc[ai][bj][m][n], 0, 0, 0, Epi::SCALE_B, 0, Epi::SCALE_A); } \
        else { _Pragma("unroll") for (int m = 0; m < 4; ++m) _Pragma("unroll") for (int n = 0; n < 2; ++n) { \
            acc[ai][bj][m][n] = __builtin_amdgcn_mfma_f32_16x16x32_bf16(frag_lo(Bt[n]), frag_lo(At[m]), acc[ai][bj][m][n], 0, 0, 0); \
            acc[ai][bj][m][n] = __builtin_amdgcn_mfma_f32_16x16x32_bf16(frag_hi(Bt[n]), frag_hi(At[m]), acc[ai][bj][m][n], 0, 0, 0); } } \
        __builtin_amdgcn_s_setprio(0); } while (0)
#define PG8_LDA(dst, b, h) PG8_LDA_(F8, dst, b, h)
#define PG8_LDB(dst, b, h) PG8_LDB_(F8, dst, b, h)
#define PG8_MMA(ai, bj, At, Bt) PG8_MMA_(F8, ai, bj, At, Bt)
#define PG8_WAIT_V(n) asm volatile("s_waitcnt vmcnt(" #n ")" ::: "memory")
#define PG8_WAIT_L(n) asm volatile("s_waitcnt lgkmcnt(" #n ")" ::: "memory")
#define PG8_BAR __builtin_amdgcn_s_barrier()
#define PG8_SCHED __builtin_amdgcn_sched_barrier(0)
    Unit cur, nxt; int ui = 0;
    if (!S.next(0, cur)) return;
    f32x4 acc[2][2][4][2];
    if constexpr (Epi::HAS_INIT) { if constexpr (!SP2) E.init(acc, cur, wr, wc, fr, fq); }
    else {
#pragma unroll
    for (int a = 0; a < 2; ++a)
#pragma unroll
        for (int b = 0; b < 2; ++b)
#pragma unroll
            for (int m = 0; m < 4; ++m)
#pragma unroll
                for (int n = 0; n < 2; ++n) acc[a][b][m][n] = (f32x4){0.f, 0.f, 0.f, 0.f};
    }
    Frag<F8 || (MIXK > 0)> At[4], B0[2], B1[2];
    unsigned vgc[2][2];
#define PG8_GATHER_OFFS(U) do { int tz_ = threadIdx.x; asm volatile("" : "+v"(tz_)); _Pragma("unroll") for (int i_ = 0; i_ < 2; ++i_) { int R_, C_; stage_rc(tz_ * 16 + i_ * 8192, R_, C_); \
        _Pragma("unroll") for (int h_ = 0; h_ < 2; ++h_) { const int rr_ = h_ * HALF + R_; const int tok_ = rr_ < (U).nvalid ? (U).rows[rr_] : 0; vgc[h_][i_] = (unsigned)tok_ * (unsigned)lda + (unsigned)(C_ * 2); } } } while (0)
    if constexpr (GATHER) PG8_GATHER_OFFS(cur);
    LAS int* const idxL = (LAS int*)(lds + STAGE_BYTES + 4096);
#define PG8_GATHER_OFFS_LDS(U) do { int tz_ = threadIdx.x; asm volatile("" : "+v"(tz_)); _Pragma("unroll") for (int i_ = 0; i_ < 2; ++i_) { int R_, C_; stage_rc(tz_ * 16 + i_ * 8192, R_, C_); \
        _Pragma("unroll") for (int h_ = 0; h_ < 2; ++h_) { const int rr_ = h_ * HALF + R_; const int tok_ = rr_ < (U).nvalid ? idxL[rr_] : 0; vgc[h_][i_] = (unsigned)tok_ * (unsigned)lda + (unsigned)(C_ * 2); } } } while (0)
    unsigned cA = cur.A, cB = cur.B;
    if constexpr (SP2) {
        PG8_STAGE(PG8_SB(0, 0), cB, voffB); PG8_STAGE(PG8_SB(0, 1), cB + hstepB, voffB); PG8_STAGE_A(0, 0, cA, vgc); PG8_STAGE_A(0, 1, cA, vgc);
        if constexpr (Epi::HAS_INIT) E.init(acc, cur, wr, wc, fr, fq);
        if (wr == 1) PG8_BAR;
        PG8_WAIT_V(2); PG8_BAR;
        PG8_STAGE(PG8_SB(1, 0), cB + kstep, voffB); PG8_STAGE_A(1, 0, cA + kstep, vgc); PG8_STAGE(PG8_SB(1, 1), cB + hstepB + kstep, voffB);
        PG8_WAIT_V(6); PG8_BAR;
    } else {
        PG8_STAGE(PG8_SB(0, 0), cB, voffB); PG8_STAGE_A(0, 0, cA, vgc); PG8_STAGE(PG8_SB(0, 1), cB + hstepB, voffB); PG8_STAGE_A(0, 1, cA, vgc);
        if (wr == 1) PG8_BAR;
        PG8_WAIT_V(4); PG8_BAR;
        PG8_STAGE(PG8_SB(1, 0), cB + kstep, voffB); PG8_STAGE_A(1, 0, cA + kstep, vgc); PG8_STAGE(PG8_SB(1, 1), cB + hstepB + kstep, voffB);
        PG8_WAIT_V(6); PG8_BAR;
    }
    for (;;) {
        const bool has_next = S.next(ui + 1, nxt);
        const unsigned nA = has_next ? nxt.A : cA, nB = has_next ? nxt.B : cB;
#define PG8_BODY(f8_) do { \
            PG8_LDB_(f8_, B0, 0, 0); PG8_LDB_(f8_, B1, 0, 1); PG8_SCHED; PG8_LDA_(f8_, At, 0, 0); PG8_STAGE_A(1, 1, a1, vgc); \
            if constexpr (GATHER) { if (last && has_next) PG8_GATHER_OFFS_LDS(nxt);      \
                if (t == 0 && has_next && wid == 0) __builtin_amdgcn_raw_ptr_buffer_load_lds(rsrc, (LAS unsigned*)idxL, 16, (int)(lane * 16), (int)nxt.rows_off, 0, 0); } \
            PG8_WAIT_V(8); PG8_WAIT_L(0); PG8_BAR; PG8_MMA_(f8_, 0, 0, At, B0); PG8_MMA_(f8_, 0, 1, At, B1); PG8_BAR; PG8_SCHED; \
            PG8_LDA_(f8_, At, 0, 1); PG8_STAGE(PG8_SB(0, 0), b2, voffB); PG8_STAGE(PG8_SB(0, 1), b2 + hstepB, voffB); PG8_STAGE_A(0, 0, a2, vgc); \
            PG8_WAIT_V(8); PG8_WAIT_L(0); PG8_BAR; PG8_MMA_(f8_, 1, 0, At, B0); PG8_MMA_(f8_, 1, 1, At, B1); PG8_BAR; PG8_SCHED; \
            PG8_LDB_(f8_, B0, 1, 0); PG8_LDB_(f8_, B1, 1, 1); PG8_SCHED; PG8_LDA_(f8_, At, 1, 0); PG8_STAGE_A(0, 1, a2, vgc); \
            PG8_WAIT_V(8); PG8_WAIT_L(0); PG8_BAR; PG8_MMA_(f8_, 0, 0, At, B0); PG8_MMA_(f8_, 0, 1, At, B1); PG8_BAR; PG8_SCHED; \
            PG8_LDA_(f8_, At, 1, 1); PG8_STAGE(PG8_SB(1, 0), b3, voffB); PG8_STAGE(PG8_SB(1, 1), b3 + hstepB, voffB); PG8_STAGE_A(1, 0, a3, vgc); \
            PG8_WAIT_V(8); PG8_WAIT_L(0); PG8_BAR; PG8_MMA_(f8_, 1, 0, At, B0); PG8_MMA_(f8_, 1, 1, At, B1); PG8_BAR; PG8_SCHED; } while (0)
        if constexpr (MIXK > 0) {
            static_assert(SP2 && !F8 && !GATHER, "mixed units: SP2 schedule, dense A");
#pragma unroll 1
            for (int t = 0; t < MIXK; t += 2) {
            const bool last = false;
            const unsigned a1 = cA + (unsigned)(t + 1) * kstep;
            const unsigned a2 = last ? nA : cA + (unsigned)(t + 2) * kstep, b2 = last ? nB : cB + (unsigned)(t + 2) * kstep;
            const unsigned a3 = a2 + kstep, b3 = b2 + kstep;
                PG8_BODY(true);
            }
#pragma unroll 1
            for (int t = MIXK; t < nt; t += 2) {
            const bool last = (t == nt - 2);
            const unsigned a1 = cA + (unsigned)(t + 1) * kstep;
            const unsigned a2 = last ? nA : cA + (unsigned)(t + 2) * kstep, b2 = last ? nB : cB + (unsigned)(t + 2) * kstep;
            const unsigned a3 = a2 + kstep, b3 = b2 + kstep;
                PG8_BODY(false);
            }
        } else {
#pragma unroll 1
        for (int t = 0; t < nt; t += 2) {
            const bool last = (t == nt - 2);
            const unsigned a1 = cA + (unsigned)(t + 1) * kstep;
            const unsigned a2 = last ? nA : cA + (unsigned)(t + 2) * kstep, b2 = last ? nB : cB + (unsigned)(t + 2) * kstep;
            const unsigned a3 = a2 + kstep, b3 = b2 + kstep;
            if constexpr (SP2) {
            PG8_BODY(F8);
            } else {
            PG8_LDB(B0, 0, 0); PG8_SCHED; PG8_LDA(At, 0, 0); PG8_STAGE_A(1, 1, a1, vgc);
            if constexpr (GATHER) { if (last && has_next) PG8_GATHER_OFFS(nxt); }
            PG8_WAIT_L(8); PG8_BAR; PG8_WAIT_L(0); PG8_MMA(0, 0, At, B0); PG8_BAR; PG8_SCHED;
            PG8_LDB(B1, 0, 1); PG8_STAGE(PG8_SB(0, 0), b2, voffB);
            PG8_BAR; PG8_WAIT_L(0); PG8_MMA(0, 1, At, B1); PG8_BAR;
            PG8_LDA(At, 0, 1); PG8_STAGE_A(0, 0, a2, vgc);
            PG8_BAR; PG8_WAIT_L(0); PG8_MMA(1, 0, At, B0); PG8_BAR; PG8_SCHED;
            PG8_STAGE(PG8_SB(0, 1), b2 + hstepB, voffB);
            PG8_WAIT_V(6); PG8_BAR; PG8_MMA(1, 1, At, B1); PG8_BAR;
            PG8_LDB(B0, 1, 0); PG8_SCHED; PG8_LDA(At, 1, 0); PG8_STAGE_A(0, 1, a2, vgc);
            PG8_WAIT_L(8); PG8_BAR; PG8_WAIT_L(0); PG8_MMA(0, 0, At, B0); PG8_BAR; PG8_SCHED;
            PG8_LDB(B1, 1, 1); PG8_STAGE(PG8_SB(1, 0), b3, voffB);
            PG8_BAR; PG8_WAIT_L(0); PG8_MMA(0, 1, At, B1); PG8_BAR;
            PG8_LDA(At, 1, 1); PG8_STAGE_A(1, 0, a3, vgc);
            PG8_BAR; PG8_WAIT_L(0); PG8_MMA(1, 0, At, B0); PG8_BAR; PG8_SCHED;
            PG8_STAGE(PG8_SB(1, 1), b3 + hstepB, voffB);
            PG8_WAIT_V(6); PG8_BAR; PG8_MMA(1, 1, At, B1); PG8_BAR;
            }
        }
        }
#undef PG8_BODY
        if (wr == 0) PG8_BAR;
        if constexpr (Epi::HAS_INIT) E.epi_init(acc, cur, nxt, has_next, wr, wc, fr, fq);
        else if constexpr (!Epi::AFTER_DRAIN) E(acc, cur, wr, wc, fr, fq);
        if (!has_next) break;
        if constexpr (!Epi::HAS_INIT) {
#pragma unroll
        for (int a = 0; a < 2; ++a)
#pragma unroll
            for (int b = 0; b < 2; ++b)
#pragma unroll
                for (int m = 0; m < 4; ++m)
#pragma unroll
                    for (int n = 0; n < 2; ++n) acc[a][b][m][n] = (f32x4){0.f, 0.f, 0.f, 0.f};
        }
        cur = nxt; cA = nA; cB = nB; ++ui;
        if (wr == 1) PG8_BAR;
    }
    PG8_WAIT_V(0);
    PG8_BAR;
    if constexpr (Epi::AFTER_DRAIN) E.fused(acc, cur, wr, wc, fr, fq, lds);
#undef PG8_SA
#undef PG8_SB
#undef PG8_STAGE
#undef PG8_STAGE_A
#undef PG8_GATHER_OFFS
#undef PG8_GATHER_OFFS_LDS
#undef PG8_LDA
#undef PG8_LDB
#undef PG8_MMA
#undef PG8_LDA_
#undef PG8_LDB_
#undef PG8_MMA_
#undef PG8_BA
#undef PG8_BB
#undef PG8_RD16
#undef PG8_WAIT_V
#undef PG8_WAIT_L
#undef PG8_BAR
#undef PG8_SCHED
}
}

struct DenseSched {
    unsigned A, B; int nM, nN, G, c; unsigned a_tile, b_tile; int pm_per_grp; unsigned b_grp;
    __device__ __forceinline__ bool next(int i, pg8::Unit& u) const {
        const long L = (long)i * G + c; if (L >= (long)nM * nN) return false;
        pg8::tile_of((int)L, nM, nN, u.pm, u.pn); u.aux = u.pm / pm_per_grp;
        u.A = A + (unsigned)u.pm * a_tile; u.B = B + (unsigned)u.aux * b_grp + (unsigned)u.pn * b_tile; u.rows = nullptr; u.rows_off = 0; u.nvalid = 0; return true;
    }
};
struct PanelSched {
    unsigned A, B; int pm, nN; unsigned a_tile, b_tile; int pm_per_grp; unsigned b_grp;
    __device__ __forceinline__ bool next(int i, pg8::Unit& u) const {
        if (i >= nN) return false;
        u.pm = pm; u.pn = i; u.aux = pm / pm_per_grp;
        u.A = A + (unsigned)pm * a_tile; u.B = B + (unsigned)u.aux * b_grp + (unsigned)i * b_tile; u.rows = nullptr; u.rows_off = 0; u.nvalid = 0; return true;
    }
};
struct MoeSched {
    unsigned A, B; const int* rows; const int* pb; int nM, nN, G, c; unsigned a_tile, b_tile, b_exp, rows_ws;
    __device__ __forceinline__ bool next(int i, pg8::Unit& u) const {
        const long L = (long)i * G + c; if (L >= (long)nM * nN) return false;
        pg8::tile_of((int)L, nM, nN, u.pm, u.pn);
        const int e = __builtin_amdgcn_readfirstlane(pb[132 + u.pm]);
        u.aux = e; u.A = A + (unsigned)u.pm * a_tile; u.B = B + (unsigned)e * b_exp + (unsigned)u.pn * b_tile;
        const int off = __builtin_amdgcn_readfirstlane(u.pm * 256 - pb[e]);
        u.rows = rows ? rows + (size_t)e * ECAP + off : nullptr; u.rows_off = rows_ws + ((unsigned)e * ECAP + (unsigned)off) * 4u; u.nvalid = __builtin_amdgcn_readfirstlane(pb[66 + e] - off); return true;
    }
};

#define EPI_ROWS_COLS_PERM() const int row0 = u.pm * 256 + wr * 64 + fr, col0 = u.pn * 256 + wc * 32 + 8 * fq
__device__ __forceinline__ u32x4 pack8(const f32x4 v0, const f32x4 v1) { u32x4 w; w.x = pg8::cvt_pk_bf16(v0[0], v0[1]); w.y = pg8::cvt_pk_bf16(v0[2], v0[3]); w.z = pg8::cvt_pk_bf16(v1[0], v1[1]); w.w = pg8::cvt_pk_bf16(v1[2], v1[3]); return w; }
struct EpiProj8 {
    static constexpr bool PERM2 = false; static constexpr bool PERM = true, AFTER_DRAIN = false, HAS_INIT = false; static constexpr int SCALE_A = 0x7f7f7f7f, SCALE_B = 0x7f7f7f7f;
    bf16* Q;
    __device__ __forceinline__ void operator()(const f32x4 (&acc)[2][2][4][2], const pg8::Unit& u, int wr, int wc, int fr, int fq) const {
        EPI_ROWS_COLS_PERM();
        const int sel = u.pn >> 1;
        const float sc = sel == 0 ? 0.125f * 0.03125f : 0.03125f;
        bf16* base = Q + (size_t)sel * ((WS_K - WS_Q) / 2);
#pragma unroll
        for (int ai = 0; ai < 2; ++ai)
#pragma unroll
            for (int m = 0; m < 4; ++m) { const int r = row0 + ai * 128 + m * 16;
#pragma unroll
                for (int bj = 0; bj < 2; ++bj) { const int c = col0 + bj * 128; const u32x4 w = pack8(acc[ai][bj][m][0] * sc, acc[ai][bj][m][1] * sc);
                    *(u32x4*)(base + (size_t)r * AW + (c & 511)) = w; } }
    }
};
struct EpiProjU {
    static constexpr bool PERM2 = false; static constexpr bool PERM = true, AFTER_DRAIN = false, HAS_INIT = false;
    bf16* UA;
    __device__ __forceinline__ void operator()(const f32x4 (&acc)[2][2][4][2], const pg8::Unit& u, int wr, int wc, int fr, int fq) const {
        EPI_ROWS_COLS_PERM();
#pragma unroll
        for (int ai = 0; ai < 2; ++ai)
#pragma unroll
            for (int m = 0; m < 4; ++m) { const int r = row0 + ai * 128 + m * 16;
#pragma unroll
                for (int bj = 0; bj < 2; ++bj) { const int cc = col0 + bj * 128, g = cc >> 4; const u32x4 w = pack8(acc[ai][bj][m][0], acc[ai][bj][m][1]);
                    *(u32x4*)(UA + ((size_t)g * NBLK + (r >> 5)) * UAW + (r & 31) * SC + (cc & 15)) = w; } }
    }
};
struct EpiGlu {
    static constexpr bool PERM2 = false; static constexpr bool PERM = true, AFTER_DRAIN = false, HAS_INIT = false;
    const bf16* G; bf16* MIX; const float* bias;
    __device__ __forceinline__ void operator()(const f32x4 (&acc)[2][2][4][2], const pg8::Unit& u, int wr, int wc, int fr, int fq) const {
        EPI_ROWS_COLS_PERM();
        u32x4 gwv[2][4][2];
#pragma unroll
        for (int ai = 0; ai < 2; ++ai)
#pragma unroll
            for (int m = 0; m < 4; ++m)
#pragma unroll
                for (int bj = 0; bj < 2; ++bj) gwv[ai][m][bj] = *(const u32x4*)(G + (size_t)(row0 + ai * 128 + m * 16) * SW + col0 + bj * 128);
#pragma unroll
        for (int bj = 0; bj < 2; ++bj) { const int c = col0 + bj * 128; const f32x4 b0 = *(const f32x4*)(bias + c), b1 = *(const f32x4*)(bias + c + 4);
#pragma unroll
            for (int ai = 0; ai < 2; ++ai)
#pragma unroll
                for (int m = 0; m < 4; ++m) { const int r = row0 + ai * 128 + m * 16;
                    const u32x4 gw = gwv[ai][m][bj]; f32x4 o0, o1;
#pragma unroll
                    for (int e = 0; e < 2; ++e) { o0[2 * e] = __uint_as_float(gw[e] << 16) * sigmoidf_(acc[ai][bj][m][0][2 * e] + b0[2 * e]); o0[2 * e + 1] = __uint_as_float(gw[e] & 0xffff0000u) * sigmoidf_(acc[ai][bj][m][0][2 * e + 1] + b0[2 * e + 1]);
                        o1[2 * e] = __uint_as_float(gw[2 + e] << 16) * sigmoidf_(acc[ai][bj][m][1][2 * e] + b1[2 * e]); o1[2 * e + 1] = __uint_as_float(gw[2 + e] & 0xffff0000u) * sigmoidf_(acc[ai][bj][m][1][2 * e + 1] + b1[2 * e + 1]); }
                    *(u32x4*)((unsigned char*)MIX + (size_t)r * MIXW + 512 + 2 * c) = pack8(o0, o1); } }
    }
};
struct EpiWout {
    static constexpr int SCALE_A = 0x7a7a7a7a, SCALE_B = 0x7a7a7a7a;
    static constexpr bool PERM2 = false; static constexpr bool PERM = true, AFTER_DRAIN = false, HAS_INIT = true;
    bf16* Z1; f32x2_t* STATS;
    __device__ __forceinline__ void init(f32x4 (&acc)[2][2][4][2], const pg8::Unit& u, int wr, int wc, int fr, int fq) const {
        EPI_ROWS_COLS_PERM();
        u32x4 xw[2][4][2];
#pragma unroll
        for (int ai = 0; ai < 2; ++ai)
#pragma unroll
            for (int m = 0; m < 4; ++m)
#pragma unroll
                for (int bj = 0; bj < 2; ++bj) xw[ai][m][bj] = *(const u32x4*)(Z1 + (size_t)(row0 + ai * 128 + m * 16) * D + col0 + bj * 128);
#pragma unroll
        for (int ai = 0; ai < 2; ++ai)
#pragma unroll
            for (int m = 0; m < 4; ++m)
#pragma unroll
                for (int bj = 0; bj < 2; ++bj) { const u32x4 w = xw[ai][m][bj]; f32x4 x0, x1;
                    x0[0] = __uint_as_float(w[0] << 16); x0[1] = __uint_as_float(w[0] & 0xffff0000u); x0[2] = __uint_as_float(w[1] << 16); x0[3] = __uint_as_float(w[1] & 0xffff0000u);
                    x1[0] = __uint_as_float(w[2] << 16); x1[1] = __uint_as_float(w[2] & 0xffff0000u); x1[2] = __uint_as_float(w[3] << 16); x1[3] = __uint_as_float(w[3] & 0xffff0000u);
                    acc[ai][bj][m][0] = x0 * ALPHA; acc[ai][bj][m][1] = x1 * ALPHA; }
    }
    __device__ __forceinline__ void epi_init(f32x4 (&acc)[2][2][4][2], const pg8::Unit& u, const pg8::Unit& un, bool has_next, int wr, int wc, int fr, int fq) const {
        const unsigned loff = (unsigned)(((wr * 64 + fr) * D + wc * 32 + 8 * fq) * 2);
        const unsigned char* zc = (const unsigned char*)Z1 + ((size_t)u.pm * 256 * D + (size_t)u.pn * 256) * 2;
        const unsigned char* zn = (const unsigned char*)Z1 + ((size_t)un.pm * 256 * D + (size_t)un.pn * 256) * 2;
        const int row0 = u.pm * 256 + wr * 64 + fr;
        u32x4 pf[8][2];
#define EW_PF(g_) do { if (has_next) { _Pragma("unroll") for (int bj_ = 0; bj_ < 2; ++bj_) pf[g_][bj_] = *(const u32x4*)(zn + (size_t)(((((g_) >> 2) * 128 + ((g_) & 3) * 16) * D + bj_ * 128) * 2) + loff); } } while (0)
#pragma unroll
        for (int g = 0; g < 8; ++g) { const int ai = g >> 2, m = g & 3; const int r = row0 + ai * 128 + m * 16; float s1 = 0.f, s2 = 0.f;
#pragma unroll
            for (int bj = 0; bj < 2; ++bj) { const f32x4 z0 = acc[ai][bj][m][0], z1 = acc[ai][bj][m][1];
#pragma unroll
                for (int e = 0; e < 4; ++e) { s1 += z0[e] + z1[e]; s2 += z0[e] * z0[e] + z1[e] * z1[e]; }
                *(u32x4*)(const_cast<unsigned char*>(zc) + (size_t)(((ai * 128 + m * 16) * D + bj * 128) * 2) + loff) = pack8(z0, z1); }
            s1 = xadd32(xadd16(s1)); s2 = xadd32(xadd16(s2));
            if (fq == 0) { f32x2_t w; w[0] = s1; w[1] = s2; STATS[(size_t)(u.pn * 4 + wc) * T + r] = w; }
            EW_PF(g);
        }
        if (has_next) {
#pragma unroll
            for (int g = 0; g < 8; ++g) { const int ai = g >> 2, m = g & 3;
#pragma unroll
                for (int bj = 0; bj < 2; ++bj) { const u32x4 w = pf[g][bj]; f32x4 x0, x1;
                    x0[0] = __uint_as_float(w[0] << 16); x0[1] = __uint_as_float(w[0] & 0xffff0000u); x0[2] = __uint_as_float(w[1] << 16); x0[3] = __uint_as_float(w[1] & 0xffff0000u);
                    x1[0] = __uint_as_float(w[2] << 16); x1[1] = __uint_as_float(w[2] & 0xffff0000u); x1[2] = __uint_as_float(w[3] << 16); x1[3] = __uint_as_float(w[3] & 0xffff0000u);
                    acc[ai][bj][m][0] = x0 * ALPHA; acc[ai][bj][m][1] = x1 * ALPHA; } }
        }
#undef EW_PF
    }
};
struct EpiGateUp {
    static constexpr bool PERM2 = false; static constexpr bool PERM = true, AFTER_DRAIN = false, HAS_INIT = false; static constexpr int SCALE_A = 0x7f7f7f7f, SCALE_B = 0x7f7f7f7f;
    fp8* HID;
    __device__ __forceinline__ void operator()(const f32x4 (&acc)[2][2][4][2], const pg8::Unit& u, int wr, int wc, int fr, int fq) const {
        const int row0 = u.pm * 256 + wr * 64 + fr + (fq & 1) * 16, col0 = u.pn * 128 + wc * 32 + 16 * (fq >> 1);
#pragma unroll
        for (int ai = 0; ai < 2; ++ai)
#pragma unroll
            for (int mp = 0; mp < 2; ++mp) { u32x2 w[2];
#pragma unroll
                for (int q = 0; q < 2; ++q) { const int m = 2 * mp + q; f32x4 o[2];
#pragma unroll
                    for (int n = 0; n < 2; ++n)
#pragma unroll
                        for (int e = 0; e < 4; ++e) { const float gt = acc[ai][0][m][n][e] * 0.03125f; o[n][e] = gt * sigmoidf_(gt) * (acc[ai][1][m][n][e] * 0.03125f); }
                    w[q].x = pk4_fp8(o[0][0], o[0][1], o[0][2], o[0][3]); w[q].y = pk4_fp8(o[1][0], o[1][1], o[1][2], o[1][3]); }
                const auto sx = __builtin_amdgcn_permlane16_swap(w[0].x, w[1].x, false, false), sy = __builtin_amdgcn_permlane16_swap(w[0].y, w[1].y, false, false);
                u32x4 o16; o16.x = sx[0]; o16.y = sy[0]; o16.z = sx[1]; o16.w = sy[1];
                *(u32x4*)(HID + (size_t)(row0 + ai * 128 + mp * 32) * DE + col0) = o16; }
    }
};
struct EpiDown {
    static constexpr bool PERM2 = true; static constexpr bool PERM = true, AFTER_DRAIN = false, HAS_INIT = false; static constexpr int SCALE_A = 0x7f7f7f7f, SCALE_B = 0x7f7f7f7f;
    fp8* O;
    __device__ __forceinline__ void operator()(const f32x4 (&acc)[2][2][4][2], const pg8::Unit& u, int wr, int wc, int fr, int fq) const {
        const int row0 = u.pm * 256 + wr * 64 + fr, col0 = u.pn * 256 + wc * 64 + 16 * fq;
#pragma unroll
        for (int ai = 0; ai < 2; ++ai)
#pragma unroll
            for (int m = 0; m < 4; ++m) { const int r = row0 + ai * 128 + m * 16; u32x4 w;
                { const f32x4 a = acc[ai][0][m][0] * 0.25f, b = acc[ai][0][m][1] * 0.25f, c = acc[ai][1][m][0] * 0.25f, d = acc[ai][1][m][1] * 0.25f;
                  w.x = pk4_fp8(a[0], a[1], a[2], a[3]); w.y = pk4_fp8(b[0], b[1], b[2], b[3]); w.z = pk4_fp8(c[0], c[1], c[2], c[3]); w.w = pk4_fp8(d[0], d[1], d[2], d[3]); }
                *(u32x4*)(O + (size_t)r * D + col0) = w; }
    }
};

struct CvtItem { const float* W; bf16* WT; int ldw, ldt, k0, n0, drow0; };
__device__ __forceinline__ void cvt_load(const CvtItem& c, f32x4 (&v)[16], int lane) {
    const int rq = lane >> 4, cq = (lane & 15) * 4;
#pragma unroll
    for (int i = 0; i < 16; ++i) v[i] = __builtin_nontemporal_load((const f32x4*)(c.W + (size_t)(c.k0 + 8 * (i >> 1) + 2 * rq + (i & 1)) * c.ldw + c.n0 + cq));
}
__device__ __forceinline__ void cvt_store(const CvtItem& c, const f32x4 (&v)[16], LAS unsigned char* tile, int lane) {
    const int rq = lane >> 4, l15 = lane & 15, sw = (l15 & 7) << 2;
#pragma unroll
    for (int m = 0; m < 8; ++m)
#pragma unroll
        for (int e = 0; e < 4; ++e) *(LAS unsigned*)(tile + (4 * l15 + e) * 128 + (((4 * m + rq) ^ sw) << 2)) = pk2(v[2 * m][e], v[2 * m + 1][e]);
    asm volatile("s_waitcnt lgkmcnt(0)" ::: "memory");
    const int ch = lane & 7;
#pragma unroll
    for (int j = 0; j < 8; ++j) { const int n = (lane >> 3) + 8 * j;
        const u32x4 o = *(const LAS u32x4*)(tile + n * 128 + ((ch ^ ((n >> 2) & 7)) << 4));
        *(u32x4*)(c.WT + (size_t)(c.drow0 + n) * c.ldt + c.k0 + 8 * ch) = o; }
    asm volatile("s_waitcnt lgkmcnt(0)" ::: "memory");
}
struct CvtItem8 { const float* W; fp8* WT; int ldw, ldt, k0, n0, drow0; };
__device__ __forceinline__ void cvt8_load(const CvtItem8& c, f32x4 (&v)[16], int lane) {
    const int rq = lane >> 4, cq = (lane & 15) * 4;
#pragma unroll
    for (int i = 0; i < 16; ++i) v[i] = __builtin_nontemporal_load((const f32x4*)(c.W + (size_t)(c.k0 + 16 * (i >> 2) + 4 * rq + (i & 3)) * c.ldw + c.n0 + cq));
}
__device__ __forceinline__ void cvt8_store(const CvtItem8& c, const f32x4 (&v)[16], LAS unsigned char* tile, int lane, const float sc = 32.f) {
    const int rq = lane >> 4, l15 = lane & 15, sw = l15 & 3;
#pragma unroll
    for (int m = 0; m < 4; ++m)
#pragma unroll
        for (int e = 0; e < 4; ++e) *(LAS unsigned*)(tile + (4 * l15 + e) * 64 + ((m ^ sw) << 4) + (rq << 2)) = pk4_fp8(v[4 * m][e] * sc, v[4 * m + 1][e] * sc, v[4 * m + 2][e] * sc, v[4 * m + 3][e] * sc);
    asm volatile("s_waitcnt lgkmcnt(0)" ::: "memory");
    const int ch = lane & 3;
#pragma unroll
    for (int j = 0; j < 4; ++j) { const int n = (lane >> 2) + 16 * j;
        const u32x4 o = *(const LAS u32x4*)(tile + n * 64 + ((ch ^ ((n >> 2) & 3)) << 4));
        __builtin_nontemporal_store(o, (u32x4*)(c.WT + (size_t)(c.drow0 + n) * c.ldt + c.k0 + 16 * ch)); }
    asm volatile("s_waitcnt lgkmcnt(0)" ::: "memory");
}
__device__ __forceinline__ void p0_item(const float* W, int ldw, bf16* WT, int ldt, int k0, int n0, int drow0, LAS unsigned char* tile, int lane) {
    CvtItem c; c.W = W; c.WT = WT; c.ldw = ldw; c.ldt = ldt; c.k0 = k0; c.n0 = n0; c.drow0 = drow0;
    f32x4 v[16]; cvt_load(c, v, lane); cvt_store(c, v, tile, lane);
}
__device__ __forceinline__ void p0_prologue(Frame& F) {
    LAS unsigned char* scr = (LAS unsigned char*)F.lds + F.wave * 16896;
    const int gw = F.bid * NWAVES + F.wave, NGW = F.G * NWAVES, lane = F.lane;
    bf16* WIN_T = (bf16*)(F.ws + WS_WIN_T); bf16* WGLU_T = (bf16*)(F.ws + WS_WGLU_T); bf16* WOUT_T = (bf16*)(F.ws + WS_WOUT_T); bf16* XB = (bf16*)(F.ws + WS_XB); fp8* XB8 = (fp8*)(F.ws + WS_XB8);
    constexpr int I_IN = 16 * 32, I_GL = 8 * 8, I_OUT = 16 * 16, NITEMS = I_IN + I_GL + I_OUT;
    for (int it = gw; it < NITEMS; it += NGW) {
        int r = it;
        if (r < I_IN) { const int kb = r / 32, nb = r % 32;
            if (nb < 24) { CvtItem8 c; c.W = F.in[I_WIN]; c.WT = (fp8*)(F.ws + WS_WIN8_T); c.ldw = INW; c.ldt = D; c.k0 = kb * 64; c.n0 = nb * 64; c.drow0 = nb * 64;
                f32x4 v[16]; cvt8_load(c, v, lane); cvt8_store(c, v, scr, lane); }
            else p0_item(F.in[I_WIN], INW, WIN_T, D, kb * 64, nb * 64, nb * 64 - 1536, scr, lane);
            continue; } r -= I_IN;
        if (r < I_GL) { const int kb = r / 8, nb = r % 8; p0_item(F.in[I_WGLU], SW, WGLU_T, SW, kb * 64, nb * 64, nb * 64, scr, lane); continue; } r -= I_GL;
        { const int kb = r / 16, nb = r % 16;
          if (kb < 8) { CvtItem8 c; c.W = F.in[I_WOUT]; c.WT = (fp8*)(F.ws + WS_WOUT_T); c.ldw = D; c.ldt = MIXW; c.k0 = kb * 64; c.n0 = nb * 64; c.drow0 = nb * 64;
              f32x4 v[16]; cvt8_load(c, v, lane); cvt8_store(c, v, scr, lane, 64.f); }
          else p0_item(F.in[I_WOUT], D, WOUT_T - 256, MIXW / 2, kb * 64, nb * 64, nb * 64, scr, lane); }
    }
    { bf16* WRT = (bf16*)(F.ws + WS_WR_T);
      for (int i = F.bid * NTHR + F.tid; i < 72 * D; i += F.G * NTHR) { const int n = i >> 10, k = i & 1023; WRT[i] = f2bf(n < 64 ? F.in[I_WRE][(size_t)k * NE + n] : F.in[I_WRG][(size_t)k * NEG + n - 64]); } }
    const float* x = F.in[I_X];
    int* qslot = (int*)(F.lds + 8 * 16896);
    __syncthreads();
    if (F.tid == 0) qslot[0] = (int)__hip_atomic_fetch_add(&F.ctl[CW_XQ], 1u, __ATOMIC_RELAXED, __HIP_MEMORY_SCOPE_AGENT);
    __syncthreads();
    for (int par = 0;; par ^= 1) {
        const int ch = qslot[par];
        if (ch >= T / 32) break;
        if (F.tid == 0) qslot[par ^ 1] = (int)__hip_atomic_fetch_add(&F.ctl[CW_XQ], 1u, __ATOMIC_RELAXED, __HIP_MEMORY_SCOPE_AGENT);
        const size_t base = (size_t)ch * 32 * D + (size_t)F.tid * 8;
        f32x4 a[8], b2[8];
#pragma unroll
        for (int j = 0; j < 8; ++j) { a[j] = __builtin_nontemporal_load((const f32x4*)(x + base + j * 4096)); b2[j] = __builtin_nontemporal_load((const f32x4*)(x + base + j * 4096 + 4)); }
#pragma unroll
        for (int j = 0; j < 8; ++j) { u32x4 o; o.x = pk2(a[j][0], a[j][1]); o.y = pk2(a[j][2], a[j][3]); o.z = pk2(b2[j][0], b2[j][1]); o.w = pk2(b2[j][2], b2[j][3]); *(u32x4*)(XB + base + j * 4096) = o;
            u32x2 o8; o8.x = pk4_fp8(a[j][0], a[j][1], a[j][2], a[j][3]); o8.y = pk4_fp8(b2[j][0], b2[j][1], b2[j][2], b2[j][3]); *(u32x2*)(XB8 + base + j * 4096) = o8; }
        __syncthreads();
    }
}
__device__ __forceinline__ CvtItem8 moe_item(Frame& F, int it) {
    constexpr int I_EXP = 16 * 8 + 16 * 8 + 8 * 16;
    fp8* WGU = (fp8*)(F.ws + WS_WGU_T); fp8* WDN = (fp8*)(F.ws + WS_WDN_T);
    const int e = it / I_EXP; int r = it - e * I_EXP; CvtItem8 c;
    if (r < 256) { const bool up = r >= 128; r &= 127; const int kb = r / 8, nb = r % 8, n0 = nb * 64;
        c.W = (up ? F.in[I_WUP] : F.in[I_WGATE]) + (size_t)e * D * DE; c.ldw = DE; c.WT = WGU + (size_t)e * 1024 * D; c.ldt = D; c.k0 = kb * 64; c.n0 = n0; c.drow0 = 256 * (n0 >> 7) + (up ? 128 : 0) + (n0 & 127); }
    else { r -= 256; const int kb = r / 16, nb = r % 16; c.W = F.in[I_WDOWN] + (size_t)e * DE * D; c.ldw = D; c.WT = WDN + (size_t)e * D * DE; c.ldt = DE; c.k0 = kb * 64; c.n0 = nb * 64; c.drow0 = nb * 64; }
    return c;
}

constexpr int MOE_NGRP = NE * (16 * 8 + 16 * 8 + 8 * 16) / 8;
__device__ __forceinline__ void moe_fill_group(Frame& F, int grp) {
    LAS unsigned char* scr = (LAS unsigned char*)F.lds + F.wave * 16896;
    const CvtItem8 c = moe_item(F, grp * 8 + F.wave);
    f32x4 v[16]; cvt8_load(c, v, F.lane); cvt8_store(c, v, scr, F.lane);
}
__device__ __forceinline__ void moe_drain(Frame& F) {
    LAS int* slot = (LAS int*)((LAS unsigned char*)F.lds + 8 * 16896);
    for (;;) {
        __syncthreads();
        if (F.tid == 0) slot[0] = (int)__hip_atomic_fetch_add(&F.ctl[CW_MQ], 1u, __ATOMIC_RELAXED, __HIP_MEMORY_SCOPE_AGENT);
        __syncthreads();
        const int grp = slot[0];
        if (grp >= MOE_NGRP) break;
        moe_fill_group(F, grp);
    }
    __syncthreads();
}
__device__ __forceinline__ void xcd_barrier_fill(const XcdBarrier& b, Frame& F) {
    asm volatile("s_waitcnt vmcnt(0)" ::: "memory");
    __syncthreads();
    volatile LAS int* role = (volatile LAS int*)((LAS unsigned char*)F.lds + 8 * 16896 + 64);
    unsigned* bar = b.bar;
    if (threadIdx.x == 0) {
        __builtin_amdgcn_s_waitcnt(0);
        unsigned nloc = b.st[0], nx = b.st[1];
        if (nloc == 0u) { xcd_barrier_complete(bar, b.x, nloc, nx); b.st[0] = nloc; b.st[1] = nx; }
        const unsigned old = xb_add(&bar[XB_XSUB(b.x)], 1u);
        const unsigned gen = old / nloc;
        const bool leader = (old + 1u == (gen + 1u) * nloc);
        role[0] = leader ? 1 : 0; role[1] = (int)gen;
        if (leader) {
            __builtin_amdgcn_fence(__ATOMIC_RELEASE, "agent");
            asm volatile("s_waitcnt vmcnt(0)" ::: "memory");
            const unsigned og = xb_add(&bar[XB_TOP], 1u);
            const unsigned tg = og / nx;
            if (og + 1u == (tg + 1u) * nx) xb_add(&bar[XB_TOPGEN], 1u);
            else XB_SPIN(xb_ld(&bar[XB_TOPGEN]) == tg, bar);
            __builtin_amdgcn_fence(__ATOMIC_ACQUIRE, "agent");
            xb_add(&bar[XB_XGEN(b.x)], 1u);
            asm volatile("s_waitcnt vmcnt(0)" ::: "memory");
        }
    }
    __syncthreads();
    if (role[0] == 0) {
        unsigned spins = 0;
        for (;;) {
            if (threadIdx.x == 0) {
                const unsigned gen = (unsigned)role[1];
                bool done = xb_ld(&bar[XB_XGEN(b.x)]) != gen;
                if (!done && ((++spins & 1023u) == 0u)) { if (xb_ld(&bar[XB_TMO])) done = true; else if (spins > XB_SPIN_CAP) { atomicAdd(&bar[XB_TMO], 1u); done = true; } }
                int grp = -1;
                if (!done) {
                    const unsigned nloc = b.st[0], nx = b.st[1];
                    const unsigned loc = xb_ld(&bar[XB_XSUB(b.x)]) - gen * nloc, top = xb_ld(&bar[XB_TOP]) - gen * nx;
                    if ((loc < nloc || top + 1u < nx) && xb_ld(&F.ctl[CW_MQ]) < (unsigned)MOE_NGRP) { const unsigned g_ = xb_add(&F.ctl[CW_MQ], 1u); if (g_ < (unsigned)MOE_NGRP) grp = (int)g_; }
                }
                role[2] = done ? 1 : 0; role[3] = grp;
            }
            __syncthreads();
            const int done = role[2], grp = role[3];
            if (done) break;
            if (grp >= 0) moe_fill_group(F, grp); else __builtin_amdgcn_s_sleep(4);
            __syncthreads();
        }
        if (threadIdx.x == 0) { __builtin_amdgcn_fence(__ATOMIC_ACQUIRE, "agent"); asm volatile("s_waitcnt vmcnt(0)" ::: "memory"); }
    }
    __syncthreads();
}

__device__ __forceinline__ void p0_s5tables_group(Frame& F, int g, int q) {
    float* PWr = (float*)F.lds;
    float* PWi = PWr + 2 * 64 * 33;
    float* BBr = PWi + 2 * 64 * 33;
    float* BBi = BBr + 2 * 64 * 16;
    float* Cr = BBi + 2 * 64 * 16;
    float* Ci = Cr + 2 * 16 * 64;
    float* KL = Ci + 2 * 16 * 64;
    float* C2r = KL + 64 * 257;
    float* C2i = C2r + 2 * 16 * 64;
    const int tid = F.tid;
    __syncthreads();
    if (tid < 128) {
        const int d = tid >> 6, p = tid & 63;
        const float ar = F.in[I_ARE][(d * SG + g) * SP + p], ai = F.in[I_AIM][(d * SG + g) * SP + p];
        const float dt = expf(F.in[I_LDT][d * SG + g]);
        const float mag = expf(ar * dt), lr = mag * cosf(ai * dt), li = mag * sinf(ai * dt);
        float pr = 1.0f, pi = 0.0f;
        for (int j = 0; j <= 32; ++j) { PWr[(d * 64 + p) * 33 + j] = pr; PWi[(d * 64 + p) * 33 + j] = pi; const float nr = pr * lr - pi * li, ni = pr * li + pi * lr; pr = nr; pi = ni; }
        const float den = ar * ar + ai * ai;
        const float zr = ((lr - 1.0f) * ar + li * ai) / den, zi = (li * ar - (lr - 1.0f) * ai) / den;
        for (int c = 0; c < SC; ++c) {
            const float br = F.in[I_BRE][((size_t)(d * SG + g) * SP + p) * SC + c], bi = F.in[I_BIM][((size_t)(d * SG + g) * SP + p) * SC + c];
            BBr[(d * 64 + p) * 16 + c] = zr * br - zi * bi; BBi[(d * 64 + p) * 16 + c] = zr * bi + zi * br;
            const float crv = F.in[I_CRE][((size_t)(d * SG + g) * SC + c) * SP + p], civ = F.in[I_CIM][((size_t)(d * SG + g) * SC + c) * SP + p];
            Cr[(d * 64 + p) * 16 + c] = crv; Ci[(d * 64 + p) * 16 + c] = civ; C2r[(d * 16 + c) * 64 + p] = crv; C2i[(d * 16 + c) * 64 + p] = civ;
        }
    }
    __syncthreads();
    for (int idx = tid; idx < 1024; idx += NTHR) {
        const int d = idx >> 9, j = (idx >> 4) & 31, c = idx & 15;
        if (d == 0 ? (j > 8 * q + 7) : (j > 31 - 8 * q)) continue;
        float acc[16];
#pragma unroll
        for (int q = 0; q < 16; ++q) acc[q] = 0.f;
        for (int p = 0; p < 64; ++p) {
            const float cr = Cr[(d * 64 + p) * 16 + c], ci = Ci[(d * 64 + p) * 16 + c], pr = PWr[(d * 64 + p) * 33 + j], pi = PWi[(d * 64 + p) * 33 + j];
            const float mr = cr * pr - ci * pi, mi = cr * pi + ci * pr;
            const f32x4* br4 = (const f32x4*)(BBr + (d * 64 + p) * 16); const f32x4* bi4 = (const f32x4*)(BBi + (d * 64 + p) * 16);
#pragma unroll
            for (int q = 0; q < 4; ++q) { const f32x4 br = br4[q], bi = bi4[q];
#pragma unroll
                for (int e = 0; e < 4; ++e) acc[4 * q + e] += mr * br[e] - mi * bi[e]; }
        }
#pragma unroll
        for (int q = 0; q < 16; ++q) KL[(d * 32 + j) * 257 + c * 16 + q] = acc[q];
    }
    __syncthreads();
    for (int part = 2 * q; part < 2 * q + 2; ++part) {
    bf16* KY = (bf16*)(F.ws + WS_KY) + (size_t)g * 512 * UAW;
    for (int o = tid; o < 64 * 64; o += NTHR) {
        const int rr = o >> 6, k0 = (o & 63) * 8, n = 64 * part + rr, t = n >> 4, c = n & 15;
        float v[8];
#pragma unroll
        for (int e = 0; e < 8; ++e) {
            const int k = k0 + e, sI = k >> 4, c2 = k & 15;
            float val = (sI <= t ? KL[(0 * 32 + (t - sI)) * 257 + c * 16 + c2] : 0.f) + (sI >= t ? KL[(1 * 32 + (sI - t)) * 257 + c * 16 + c2] : 0.f);
            if (sI == t && c == c2) val += F.in[I_SD][g * SC + c];
            v[e] = val;
        }
        u32x4 w; w.x = pk2(v[0], v[1]); w.y = pk2(v[2], v[3]); w.z = pk2(v[4], v[5]); w.w = pk2(v[6], v[7]);
        *(u32x4*)(KY + (size_t)n * UAW + k0) = w;
    }
    for (int o = tid; o < 64 * 4 * 64; o += NTHR) {
        const int p = o & 63, seg = (o >> 6) & 3, rr = o >> 8, n = 64 * part + rr, t = n >> 4, c = n & 15, d = seg >> 1, im = seg & 1, j = d == 0 ? t + 1 : 32 - t;
        const float cr = C2r[(d * 16 + c) * 64 + p], ci = C2i[(d * 16 + c) * 64 + p], pr = PWr[(d * 64 + p) * 33 + j], pi = PWi[(d * 64 + p) * 33 + j];
        KY[(size_t)n * UAW + 512 + seg * 64 + p] = f2bf(im ? -(cr * pi + ci * pr) : (cr * pr - ci * pi));
    }
    bf16* WE = (bf16*)(F.ws + WS_WE) + (size_t)g * 256 * 512;
    for (int o = tid; o < 32 * 64; o += NTHR) {
        const int rr = o >> 6, k0 = (o & 63) * 8, n = 32 * part + rr, seg = n >> 6, p = n & 63, d = seg >> 1, im = seg & 1;
        float v[8];
#pragma unroll
        for (int e = 0; e < 8; ++e) { const int k = k0 + e, sI = k >> 4, c2 = k & 15, j = d == 0 ? 31 - sI : sI;
            const float pr = PWr[(d * 64 + p) * 33 + j], pi = PWi[(d * 64 + p) * 33 + j], br = BBr[(d * 64 + p) * 16 + c2], bi = BBi[(d * 64 + p) * 16 + c2];
            v[e] = im ? (pr * bi + pi * br) : (pr * br - pi * bi); }
        u32x4 w; w.x = pk2(v[0], v[1]); w.y = pk2(v[2], v[3]); w.z = pk2(v[4], v[5]); w.w = pk2(v[6], v[7]);
        *(u32x4*)(WE + (size_t)n * 512 + k0) = w;
    }
    }
    if (q == 0 && tid < 128) { const int d = tid >> 6, p = tid & 63; float* L = (float*)(F.ws + WS_S5TAB) + ((size_t)(g * 2 + d) * 64 + p) * 2; L[0] = PWr[(d * 64 + p) * 33 + 32]; L[1] = PWi[(d * 64 + p) * 33 + 32]; }
    __syncthreads();
}
__device__ __forceinline__ void p0_s5tables(Frame& F) { for (int it = F.bid; it < SG * 4; it += F.G) p0_s5tables_group(F, it >> 2, it & 3); }

struct EpiS5E {
    static constexpr bool PERM2 = false; static constexpr bool PERM = false, AFTER_DRAIN = false, HAS_INIT = false;
    float* E;
    __device__ __forceinline__ void operator()(const f32x4 (&acc)[2][2][4][2], const pg8::Unit& u, int wr, int wc, int fr, int fq) const {
        const int row0 = u.pm * 256 + wr * 64 + fr, col0 = wc * 32 + 4 * fq;
#pragma unroll
        for (int ai = 0; ai < 2; ++ai)
#pragma unroll
            for (int m = 0; m < 4; ++m) { float* rowp = E + (size_t)(row0 + ai * 128 + m * 16) * 256 + col0;
#pragma unroll
                for (int bj = 0; bj < 2; ++bj)
#pragma unroll
                    for (int n = 0; n < 2; ++n) *(f32x4*)(rowp + bj * 128 + n * 16) = acc[ai][bj][m][n]; }
    }
};
struct EpiS5Y {
    static constexpr bool PERM2 = false; static constexpr bool PERM = true, AFTER_DRAIN = false, HAS_INIT = false;
    bf16* G;
    __device__ __forceinline__ void operator()(const f32x4 (&acc)[2][2][4][2], const pg8::Unit& u, int wr, int wc, int fr, int fq) const {
        EPI_ROWS_COLS_PERM();
#pragma unroll
        for (int ai = 0; ai < 2; ++ai)
#pragma unroll
            for (int m = 0; m < 4; ++m) { const int r = row0 + ai * 128 + m * 16, g = r >> 11, blk = r & 2047;
#pragma unroll
                for (int bj = 0; bj < 2; ++bj) { const int c = col0 + bj * 128, t = c >> 4, ch = c & 15; f32x4 o0, o1;
#pragma unroll
                    for (int e = 0; e < 4; ++e) { o0[e] = gelu_tanh(acc[ai][bj][m][0][e]); o1[e] = gelu_tanh(acc[ai][bj][m][1][e]); }
                    *(u32x4*)(G + ((size_t)blk * TB + t) * SW + g * SC + ch) = pack8(o0, o1); } }
    }
};

struct EpiS5EScan {
    static constexpr bool PERM2 = false; static constexpr bool PERM = false, AFTER_DRAIN = true, HAS_INIT = false;
    bf16* UA; const float* L32;
    __device__ __forceinline__ void fused(const f32x4 (&acc)[2][2][4][2], const pg8::Unit& u, int wr, int wc, int fr, int fq, LAS unsigned char* lds) const {
        LAS float* Eb = (LAS float*)lds;
        const int g = u.pm >> 3, p = threadIdx.x & 63;
        const size_t rowbase = (size_t)u.pm * 256;
#pragma unroll
        for (int d = 0; d < 2; ++d) {
            const float lr = L32[((size_t)(g * 2 + d) * 64 + p) * 2], li = L32[((size_t)(g * 2 + d) * 64 + p) * 2 + 1];
#pragma unroll
            for (int ai = 0; ai < 2; ++ai)
#pragma unroll
                for (int m = 0; m < 4; ++m)
#pragma unroll
                    for (int n = 0; n < 2; ++n) *(LAS f32x4*)(Eb + (ai * 128 + wr * 64 + m * 16 + fr) * 128 + wc * 32 + n * 16 + 4 * fq) = acc[ai][d][m][n];
            __syncthreads();
            if (threadIdx.x < 64) {
                float hr = 0.f, hi = 0.f;
                for (int k0 = 0; k0 < 256; k0 += 8) {
                    float er[8], ei[8];
#pragma unroll
                    for (int i = 0; i < 8; ++i) { const int k = d == 0 ? k0 + i : 255 - (k0 + i); er[i] = Eb[k * 128 + p]; ei[i] = Eb[k * 128 + 64 + p]; }
#pragma unroll
                    for (int i = 0; i < 8; ++i) { const int k = d == 0 ? k0 + i : 255 - (k0 + i);
                        bf16* o = UA + (rowbase + k) * UAW + 512 + d * 128; o[p] = f2bf(hr); o[64 + p] = f2bf(hi);
                        const float nr = lr * hr - li * hi + er[i], ni = lr * hi + li * hr + ei[i]; hr = nr; hi = ni; }
                }
            }
            __syncthreads();
        }
    }
};
__device__ __forceinline__ void f_s5e(Frame& F) {
    DenseSched S{(unsigned)WS_UA, (unsigned)WS_WE, T / 256, 1, F.G, F.bid, 256u * UAW * 2, 0u, 8, 256u * 512 * 2};
    if (F.G >= T / 256) {
        EpiS5EScan E{(bf16*)(F.ws + WS_UA), (const float*)(F.ws + WS_S5TAB)};
        pg8::gemm_phase<EpiS5EScan, DenseSched, false>((LAS unsigned char*)F.lds, F.ws, UAW * 2, 512 * 2, 512 / 64, S, E);
        if (F.bid < T / 256) {
            int pm, pn; pg8::tile_of(F.bid, T / 256, 1, pm, pn);
            asm volatile("s_waitcnt vmcnt(0)" ::: "memory");
            __syncthreads();
            PanelSched S2{(unsigned)WS_UA, (unsigned)WS_KY, pm, 2, 256u * UAW * 2, 256u * UAW * 2, 8, 512u * UAW * 2};
            EpiS5Y E2{(bf16*)(F.ws + WS_G)};
            pg8::gemm_phase<EpiS5Y, PanelSched, false, false, ENG_SP2>((LAS unsigned char*)F.lds, F.ws, UAW * 2, UAW * 2, UAW / 64, S2, E2);
        }
    } else {
        EpiS5E E{(float*)(F.ws + WS_E)};
        pg8::gemm_phase<EpiS5E, DenseSched, false>((LAS unsigned char*)F.lds, F.ws, UAW * 2, 512 * 2, 512 / 64, S, E);
    }
}
__device__ __forceinline__ void f_s5y(Frame& F) {
    DenseSched S{(unsigned)WS_UA, (unsigned)WS_KY, T / 256, 2, F.G, F.bid, 256u * UAW * 2, 256u * UAW * 2, 8, 512u * UAW * 2};
    EpiS5Y E{(bf16*)(F.ws + WS_G)};
    pg8::gemm_phase<EpiS5Y, DenseSched, false, false, ENG_SP2>((LAS unsigned char*)F.lds, F.ws, UAW * 2, UAW * 2, UAW / 64, S, E);
}
__device__ __forceinline__ void f_s5scan(Frame& F) {
    const float* E = (const float*)(F.ws + WS_E); bf16* UA = (bf16*)(F.ws + WS_UA); const float* L32 = (const float*)(F.ws + WS_S5TAB);
    const int per = (NBATCH * SG * 2 * SP + F.G - 1) / F.G;
    if (F.tid >= per) return;
    const int id = F.bid * per + F.tid; if (id >= NBATCH * SG * 2 * SP) return;
    const int p = id & 63, d = (id >> 6) & 1, g = (id >> 7) & 31, b = id >> 12;
    const float lr = L32[((size_t)(g * 2 + d) * 64 + p) * 2], li = L32[((size_t)(g * 2 + d) * 64 + p) * 2 + 1];
    float hr = 0.f, hi = 0.f;
    const size_t rowbase = (size_t)g * NBLK + (size_t)b * 256;
    const int colr = d * 128 + p, coli = colr + 64;
    for (int k0 = 0; k0 < 256; k0 += 8) {
        float er[8], ei[8];
#pragma unroll
        for (int i = 0; i < 8; ++i) { const int k = d == 0 ? k0 + i : 255 - (k0 + i); er[i] = E[(rowbase + k) * 256 + colr]; ei[i] = E[(rowbase + k) * 256 + coli]; }
#pragma unroll
        for (int i = 0; i < 8; ++i) { const int k = d == 0 ? k0 + i : 255 - (k0 + i);
            bf16* o = UA + (rowbase + k) * UAW + 512; o[colr] = f2bf(hr); o[coli] = f2bf(hi);
            const float nr = lr * hr - li * hi + er[i], ni = lr * hi + li * hr + ei[i]; hr = nr; hi = ni; }
    }
}


__device__ __forceinline__ s16x4 vtr(LAS const unsigned char* p) { return __builtin_bit_cast(s16x4, __builtin_amdgcn_ds_read_tr16_b64_v4i16((LAS s16x4*)p)); }
__device__ __forceinline__ void f_attn(Frame& F) {
    LAS unsigned char* L = (LAS unsigned char*)F.lds;
    constexpr int RSL = 5120, NSL = 15, KOFF = 0, VOFF = NSL * RSL, ROFF = 2 * NSL * RSL;
    const bf16* Q = (const bf16*)(F.ws + WS_Q); const bf16* Kb = (const bf16*)(F.ws + WS_K); const bf16* Vb = (const bf16*)(F.ws + WS_V);
    bf16* MIX = (bf16*)(F.ws + WS_MIX); const float* rpb = F.in[I_RPB];
    LAS float* rpbL = (LAS float*)(L + ROFF);
    const int w = F.wave, lane = F.lane, g = lane >> 4, li = lane & 15, ro = w >> 1, wl = (w & 1) * 8;
    const unsigned pcol = (unsigned)(lane >> 3);
    const unsigned ksrc = pcol * (AW * 2) + ((unsigned)((lane & 7) ^ (lane >> 3)) << 4);
    const unsigned vsrc = pcol * (AW * 2) + ((unsigned)(2 * (((lane & 7) >> 1) ^ ((lane >> 4) & 3)) + (lane & 1)) << 4);
    const int kb0 = (wl + li) * 128 + (((0 + g) ^ (li & 7)) << 4), kb1 = (wl + li) * 128 + (((4 + g) ^ (li & 7)) << 4);
    const int q4 = li >> 2, p4 = li & 3, sw = (2 * g + (q4 >> 1)) & 3;
    const int vb = (wl + 4 * g + q4) * 128 + p4 * 8;
    int vo[4];
#pragma unroll
    for (int dt = 0; dt < 4; ++dt) vo[dt] = vb + ((dt ^ sw) << 5);
    const int NU = NBATCH * NH * 2 * (ROWS / 4);
    const int per = (NU + F.G - 1) / F.G;
    const int ub = F.bid * per, u1 = (F.bid + 1) * per < NU ? (F.bid + 1) * per : NU;
#define ATT_RS(r_) ((r_) - 4 < 0 ? 0 : ((r_) - 4 > ROWS - 8 ? ROWS - 8 : (r_) - 4))
#define ATT_STAGE_ROWS(row_lo, nrows) do { const int np_ = 10 * (nrows); for (int pi_ = w; pi_ < np_; pi_ += NWAVES) { const int ri_ = pi_ / 5, pc_ = pi_ - ri_ * 5; const bool isv_ = ri_ >= (nrows); const int row_ = (row_lo) + (isv_ ? ri_ - (nrows) : ri_); \
        __builtin_amdgcn_global_load_lds((const unsigned*)((isv_ ? vg : kg) + (size_t)row_ * (GW * AW * 2) + (size_t)pc_ * 8 * (AW * 2)), (LAS unsigned*)(L + (isv_ ? VOFF : KOFF) + (row_ % NSL) * RSL + pc_ * 1024), 16, 0, 0); } } while (0)
    pg8::bf16x8 qf[2], qn[2];
    qn[0] = qn[1] = (pg8::bf16x8){0, 0, 0, 0, 0, 0, 0, 0};
    int boff[2][4]; int c = 0;
    for (int u = ub; u < u1; ++u) {
        const int bhh = u >> 5, rg = u & 31, ch = bhh & 1, h = (bhh >> 1) & 7, b = bhh >> 4, r0 = rg * 4;
        const bool full = (u == ub) || (rg == 0);
        const bool nsame = (u + 1 < u1) && (((u + 1) & 31) != 0);
        const int cw0 = ch ? 24 : 0;
        const char* kg = (const char*)Kb + ((size_t)(b * SEQ + cw0) * AW + h * HD) * 2 + ksrc;
        const char* vg = (const char*)Vb + ((size_t)(b * SEQ + cw0) * AW + h * HD) * 2 + vsrc;
        const int rlo = ATT_RS(r0), rhi = ATT_RS(r0 + 3) + 7;
        const int r = r0 + ro, rsr = ATT_RS(r);
        if (full) {
            const int qt = 2 * ch + (w & 1), wbg = qt == 0 ? 0 : (qt == 1 ? 8 : (qt == 2 ? 24 : 32));
            c = 16 * qt + li; int cs = c - 8; cs = cs < 0 ? 0 : (cs > GW - 16 ? GW - 16 : cs);
#pragma unroll
            for (int hh = 0; hh < 2; ++hh)
#pragma unroll
                for (int e = 0; e < 4; ++e) { const int kc = wbg + 16 * hh + 4 * g + e; boff[hh][e] = (kc >= cs && kc < cs + 16) ? (kc - c + 15) * 4 : 15 * 31 * 4; }
            __syncthreads();
            ATT_STAGE_ROWS(rlo, rhi - rlo + 1);
            if (F.tid < 15 * 31) { rpbL[F.tid] = rpb[h * 15 * 31 + F.tid] * 1.4426950408889634f; rpbL[15 * 31 + F.tid] = -1e30f; }
            const size_t tq0 = (size_t)b * SEQ + (size_t)r * GW + c;
            qf[0] = *(const pg8::bf16x8*)(Q + tq0 * AW + h * HD + 8 * g); qf[1] = *(const pg8::bf16x8*)(Q + tq0 * AW + h * HD + 32 + 8 * g);
        } else { qf[0] = qn[0]; qf[1] = qn[1]; }
        const size_t tq = (size_t)b * SEQ + (size_t)r * GW + c;
        asm volatile("s_waitcnt vmcnt(0)" ::: "memory");
        __syncthreads();
        if (nsame) { const int nhi = ATT_RS(r0 + 7) + 7;
            if (nhi > rhi) ATT_STAGE_ROWS(rhi + 1, nhi - rhi);
            const size_t tn = tq + 4 * GW;
            qn[0] = *(const pg8::bf16x8*)(Q + tn * AW + h * HD + 8 * g); qn[1] = *(const pg8::bf16x8*)(Q + tn * AW + h * HD + 32 + 8 * g); }
        int sl0 = rsr % NSL;
        f32x4 sacc[8][2];
        float mx = -1e30f;
        int baddr[2][4];
#pragma unroll
        for (int hh = 0; hh < 2; ++hh)
#pragma unroll
            for (int e = 0; e < 4; ++e) baddr[hh][e] = ROFF + boff[hh][e] + (rsr - r + 7) * 124;
#pragma unroll
        for (int i = 0; i < 8; ++i) {
            const int slot = sl0 + i >= NSL ? sl0 + i - NSL : sl0 + i;
#pragma unroll
            for (int hh = 0; hh < 2; ++hh) {
                const pg8::bf16x8 k0 = *(const LAS pg8::bf16x8*)(L + KOFF + slot * RSL + hh * 2048 + kb0), k1 = *(const LAS pg8::bf16x8*)(L + KOFF + slot * RSL + hh * 2048 + kb1);
                f32x4 a = (f32x4){0.f, 0.f, 0.f, 0.f};
                a = __builtin_amdgcn_mfma_f32_16x16x32_bf16(k0, qf[0], a, 0, 0, 0);
                a = __builtin_amdgcn_mfma_f32_16x16x32_bf16(k1, qf[1], a, 0, 0, 0);
#pragma unroll
                for (int e = 0; e < 4; ++e) { a[e] = a[e] * 1.4426950408889634f + *(const LAS float*)(L + baddr[hh][e] + i * 124); mx = fmaxf(mx, a[e]); }
                sacc[i][hh] = a;
            }
        }
        mx = xmax32(xmax16(mx));
        float lsum = 0.f;
#pragma unroll
        for (int i = 0; i < 8; ++i)
#pragma unroll
            for (int hh = 0; hh < 2; ++hh)
#pragma unroll
                for (int e = 0; e < 4; ++e) { const float pv = __builtin_amdgcn_exp2f(sacc[i][hh][e] - mx); sacc[i][hh][e] = pv; lsum += pv; }
        lsum = xadd32(xadd16(lsum));
        f32x4 oacc[4];
#pragma unroll
        for (int dt = 0; dt < 4; ++dt) oacc[dt] = (f32x4){0.f, 0.f, 0.f, 0.f};
#pragma unroll
        for (int i = 0; i < 8; ++i) {
            const int slot = sl0 + i >= NSL ? sl0 + i - NSL : sl0 + i;
            const u32x4 pw = pack8(sacc[i][0], sacc[i][1]);
            const pg8::bf16x8 pf = __builtin_bit_cast(pg8::bf16x8, pw);
#pragma unroll
            for (int dt = 0; dt < 4; ++dt) {
                const s16x4 v0 = vtr(L + VOFF + slot * RSL + vo[dt]), v1 = vtr(L + VOFF + slot * RSL + 2048 + vo[dt]);
                const pg8::bf16x8 vf = (pg8::bf16x8){v0[0], v0[1], v0[2], v0[3], v1[0], v1[1], v1[2], v1[3]};
                oacc[dt] = __builtin_amdgcn_mfma_f32_16x16x32_bf16(vf, pf, oacc[dt], 0, 0, 0);
            }
        }
        const float inv = 16.0f / lsum;
#pragma unroll
        for (int dt = 0; dt < 4; ++dt) *(unsigned*)((unsigned char*)MIX + tq * MIXW + h * HD + 16 * dt + 4 * g) = pk4_fp8(oacc[dt][0] * inv, oacc[dt][1] * inv, oacc[dt][2] * inv, oacc[dt][3] * inv);
    }
#undef ATT_STAGE_ROWS
#undef ATT_RS
    asm volatile("s_waitcnt vmcnt(0)" ::: "memory");
    __syncthreads();
}

__device__ __forceinline__ void f_ln1_router(Frame& F) {
    LAS unsigned char* L = (LAS unsigned char*)F.lds;
    constexpr int WOFF = 0, GBOFF = 72 * 2048, HOFF = GBOFF + 8192;
    const bf16* Z1 = (const bf16*)(F.ws + WS_Z1); fp8* H1F = (fp8*)(F.ws + WS_H1F); const bf16* WRT = (const bf16*)(F.ws + WS_WR_T);
    int* tokE = (int*)(F.ws + WS_TOKE); int* tokPos = (int*)(F.ws + WS_TOKPOS); float* tokW = (float*)(F.ws + WS_TOKW); int* elist = (int*)(F.ws + WS_ELIST);
    unsigned* counts = F.ctl + CW_CNT;
    LAS float* GB = (LAS float*)(L + GBOFF);
    LAS int* hist = (LAS int*)(L + HOFF); LAS int* base = hist + 64; LAS int* lE = base + 64; LAS int* lR = lE + 512; LAS float* lW = (LAS float*)(lR + 512);
    const int lane = F.lane, tk = lane & 15, g = lane >> 4;
    __syncthreads();
    { u32x4 wt[18]; float gb[4];
#pragma unroll
      for (int j = 0; j < 18; ++j) { const int i = F.tid + j * NTHR, n = i >> 7, ch = i & 127; wt[j] = *(const u32x4*)(WRT + (size_t)n * D + ch * 8); }
#pragma unroll
      for (int j = 0; j < 4; ++j) { const int i = F.tid + j * NTHR; gb[j] = j < 2 ? F.in[I_LN1G][i] : F.in[I_LN1B][i - 1024]; }
#pragma unroll
      for (int j = 0; j < 18; ++j) { const int i = F.tid + j * NTHR, n = i >> 7, ch = i & 127; *(LAS u32x4*)(L + WOFF + n * 2048 + ((ch ^ (n & 15)) << 4)) = wt[j]; }
#pragma unroll
      for (int j = 0; j < 4; ++j) GB[F.tid + j * NTHR] = gb[j]; }
    __syncthreads();
    int brow[5];
#pragma unroll
    for (int t = 0; t < 5; ++t) brow[t] = t < 4 ? 16 * t + tk : 64 + (tk & 7);
    const float be0 = F.in[I_BRE2][tk], be1 = F.in[I_BRE2][16 + tk], be2 = F.in[I_BRE2][32 + tk], be3 = F.in[I_BRE2][48 + tk], bg = F.in[I_BRG][tk & 7];
    for (int chunk = F.bid; chunk < T / 256; chunk += F.G) {
        if (F.tid < 64) hist[F.tid] = 0;
        __syncthreads();
#pragma unroll 1
        for (int grp = 0; grp < 2; ++grp) {
            const int tl0 = F.wave * 32 + grp * 16, t0 = chunk * 256 + tl0;
            const bf16* zp = Z1 + (size_t)(t0 + tk) * D + 8 * g;
            u32x4 fa[4], fb[4];
#pragma unroll
            for (int i_ = 0; i_ < 4; ++i_) fa[i_] = *(const u32x4*)(zp + 32 * i_);
            float s1 = 0.f, s2 = 0.f;
            { const f32x2_t* sp = (const f32x2_t*)(F.ws + WS_STATS) + (size_t)(4 * g) * T + (t0 + tk);
#pragma unroll
              for (int j = 0; j < 4; ++j) { const f32x2_t pj = sp[(size_t)j * T]; s1 += pj[0]; s2 += pj[1]; } }
            s1 = xadd32(xadd16(s1)); s2 = xadd32(xadd16(s2));
            const float mean = s1 * (1.0f / D), var = s2 * (1.0f / D) - mean * mean, rstd = rsqrtf(var + LN_EPS);
            if (g == 0) { f32x2_t mr; mr[0] = mean; mr[1] = rstd; ((f32x2_t*)(F.ws + WS_MR))[t0 + tk] = mr; }
            f32x4 acc[5];
#pragma unroll
            for (int t = 0; t < 5; ++t) acc[t] = (f32x4){0.f, 0.f, 0.f, 0.f};
            fp8* hp8 = H1F + (size_t)(t0 + tk) * D + 8 * g;
#define RT_LOAD(dst, blk) do { _Pragma("unroll") for (int i_ = 0; i_ < 4; ++i_) dst[i_] = *(const u32x4*)(zp + 32 * ((blk) * 4 + i_)); } while (0)
#define RT_PROC(src, blk) do { _Pragma("unroll") for (int i_ = 0; i_ < 4; ++i_) { const int sI = (blk) * 4 + i_; const u32x4 f = src[i_]; \
                const int k = 32 * sI + 8 * g; \
                const f32x4 g0 = *(const LAS f32x4*)(GB + k), g1 = *(const LAS f32x4*)(GB + k + 4), b0 = *(const LAS f32x4*)(GB + 1024 + k), b1 = *(const LAS f32x4*)(GB + 1024 + k + 4); \
                f32x4 v0, v1; \
                v0[0] = (__uint_as_float(f[0] << 16) - mean) * rstd * g0[0] + b0[0]; v0[1] = (__uint_as_float(f[0] & 0xffff0000u) - mean) * rstd * g0[1] + b0[1]; \
                v0[2] = (__uint_as_float(f[1] << 16) - mean) * rstd * g0[2] + b0[2]; v0[3] = (__uint_as_float(f[1] & 0xffff0000u) - mean) * rstd * g0[3] + b0[3]; \
                v1[0] = (__uint_as_float(f[2] << 16) - mean) * rstd * g1[0] + b1[0]; v1[1] = (__uint_as_float(f[2] & 0xffff0000u) - mean) * rstd * g1[1] + b1[1]; \
                v1[2] = (__uint_as_float(f[3] << 16) - mean) * rstd * g1[2] + b1[2]; v1[3] = (__uint_as_float(f[3] & 0xffff0000u) - mean) * rstd * g1[3] + b1[3]; \
                const u32x4 hw = pack8(v0, v1); \
                { u32x2 w8; w8.x = pk4_fp8(v0[0], v0[1], v0[2], v0[3]); w8.y = pk4_fp8(v1[0], v1[1], v1[2], v1[3]); *(u32x2*)(hp8 + 32 * sI) = w8; } \
                const pg8::bf16x8 af = __builtin_bit_cast(pg8::bf16x8, hw); \
                const int ch = 4 * sI + g; \
                _Pragma("unroll") for (int t = 0; t < 5; ++t) { const pg8::bf16x8 bfr = *(const LAS pg8::bf16x8*)(L + WOFF + brow[t] * 2048 + ((ch ^ (brow[t] & 15)) << 4)); \
                    acc[t] = __builtin_amdgcn_mfma_f32_16x16x32_bf16(af, bfr, acc[t], 0, 0, 0); } } } while (0)
            {
#pragma unroll 1
              for (int blk = 0; blk < 8; blk += 2) {
                  RT_LOAD(fb, blk + 1);
                  RT_PROC(fa, blk);
                  if (blk + 2 < 8) RT_LOAD(fa, blk + 2);
                  RT_PROC(fb, blk + 1);
              } }
#undef RT_LOAD
#undef RT_PROC
#pragma unroll
            for (int r = 0; r < 4; ++r) {
                float gv = acc[4][r] + bg; int gi = tk & 7;
                const float gown = gv;
#pragma unroll
                for (int m = 1; m < 8; m <<= 1) { const float ov = __shfl_xor(gv, m); const int oi = __shfl_xor(gi, m); const bool take = ov > gv || (ov == gv && oi < gi); gv = take ? ov : gv; gi = take ? oi : gi; }
                float ge = __expf(gown - gv);
#pragma unroll
                for (int m = 1; m < 8; m <<= 1) ge += __shfl_xor(ge, m);
                const float gval = 1.0f / ge;
                const int tsel = gi >> 1;
                float ev = tsel == 0 ? acc[0][r] + be0 : (tsel == 1 ? acc[1][r] + be1 : (tsel == 2 ? acc[2][r] + be2 : acc[3][r] + be3));
                if ((tk >> 3) != (gi & 1)) ev = -3e38f;
                float v1 = ev; int i1 = tk & 7;
#pragma unroll
                for (int m = 1; m < 16; m <<= 1) { const float ov = __shfl_xor(v1, m); const int oi = __shfl_xor(i1, m); const bool take = ov > v1 || (ov == v1 && oi < i1); v1 = take ? ov : v1; i1 = take ? oi : i1; }
                float ev2 = ((tk & 7) == i1) ? -3e38f : ev; float v2 = ev2; int i2 = tk & 7;
#pragma unroll
                for (int m = 1; m < 16; m <<= 1) { const float ov = __shfl_xor(v2, m); const int oi = __shfl_xor(i2, m); const bool take = ov > v2 || (ov == v2 && oi < i2); v2 = take ? ov : v2; i2 = take ? oi : i2; }
                if (tk == 0) {
                    const float ex = __expf(v2 - v1), w0 = gval / (1.0f + ex), w1 = gval * ex / (1.0f + ex);
                    const int tl = tl0 + 4 * g + r, E0 = gi * EPG + i1, E1 = gi * EPG + i2;
                    lE[2 * tl] = E0; lE[2 * tl + 1] = E1; lW[2 * tl] = w0; lW[2 * tl + 1] = w1;
                    lR[2 * tl] = atomicAdd((int*)&hist[E0], 1); lR[2 * tl + 1] = atomicAdd((int*)&hist[E1], 1);
                }
            }
        }
        __syncthreads();
        if (F.tid < 64) base[F.tid] = (int)__hip_atomic_fetch_add(&counts[F.tid], (unsigned)hist[F.tid], __ATOMIC_RELAXED, __HIP_MEMORY_SCOPE_AGENT);
        __syncthreads();
        { const int a = F.tid, ga = chunk * 512 + a; const int e = lE[a], pos = base[e] + lR[a]; tokE[ga] = e; tokPos[ga] = pos; tokW[ga] = lW[a]; elist[(size_t)e * ECAP + pos] = ga >> 1; }
        __syncthreads();
    }
}

__device__ __forceinline__ void f_proj(Frame& F) {
    static_assert(WS_V - WS_K == WS_K - WS_Q, "Q|K|V spacing");
    { DenseSched S{(unsigned)WS_XB8, (unsigned)WS_WIN8_T, T / 256, 1536 / 256, F.G, F.bid, 256u * D, 256u * D, 1 << 30, 0};
      EpiProj8 E{(bf16*)(F.ws + WS_Q)};
      pg8::gemm_phase<EpiProj8, DenseSched, false, true>((LAS unsigned char*)F.lds, F.ws, D, D, D / 128, S, E); }
    { DenseSched S{(unsigned)WS_XB, (unsigned)WS_WIN_T, T / 256, SW / 256, F.G, F.bid, 256u * D * 2, 256u * D * 2, 1 << 30, 0};
      EpiProjU E{(bf16*)(F.ws + WS_UA)};
      pg8::gemm_phase<EpiProjU, DenseSched, false, false, ENG_SP2>((LAS unsigned char*)F.lds, F.ws, D * 2, D * 2, D / 64, S, E); }
}
__device__ __forceinline__ void f_glu(Frame& F) {
    DenseSched S{(unsigned)WS_G, (unsigned)WS_WGLU_T, T / 256, SW / 256, F.G, F.bid, 256u * SW * 2, 256u * SW * 2, 1 << 30, 0};
    EpiGlu E{(const bf16*)(F.ws + WS_G), (bf16*)(F.ws + WS_MIX), F.in[I_BGLU]};
    pg8::gemm_phase<EpiGlu, DenseSched, false, false, ENG_SP2>((LAS unsigned char*)F.lds, F.ws, SW * 2, SW * 2, SW / 64, S, E);
}
__device__ __forceinline__ void f_wout(Frame& F) {
    DenseSched S{(unsigned)WS_MIX, (unsigned)WS_WOUT_T, T / 256, D / 256, F.G, F.bid, 256u * MIXW, 256u * MIXW, 1 << 30, 0};
    EpiWout E{(bf16*)(F.ws + WS_Z1), (f32x2_t*)(F.ws + WS_STATS)};
    static_assert(WS_Z1 == WS_XB, "Z1 overlays XB");
    pg8::gemm_phase<EpiWout, DenseSched, false, false, ENG_SP2, 4>((LAS unsigned char*)F.lds, F.ws, MIXW, MIXW, MIXW / 128, S, E);
}
__device__ __forceinline__ void f_gateup(Frame& F) {
    int* pb = (int*)(F.lds + pg8::STAGE_BYTES);
    load_pbase(F, pb);
    MoeSched S{(unsigned)WS_H1F, (unsigned)WS_WGU_T, (const int*)(F.ws + WS_ELIST), pb, pb[64] / 256, 4, F.G, F.bid, 0u, 256u * D, 1024u * D, (unsigned)WS_ELIST};
    EpiGateUp E{(fp8*)(F.ws + WS_HID)};
    pg8::gemm_phase<EpiGateUp, MoeSched, true, true>((LAS unsigned char*)F.lds, F.ws, D, D, D / 128, S, E);
}
__device__ __forceinline__ void f_down(Frame& F) {
    int* pb = (int*)(F.lds + pg8::STAGE_BYTES);
    load_pbase(F, pb);
    MoeSched S{(unsigned)WS_HID, (unsigned)WS_WDN_T, nullptr, pb, pb[64] / 256, 4, F.G, F.bid, 256u * DE, 256u * DE, (unsigned)D * DE, 0u};
    EpiDown E{(fp8*)(F.ws + WS_O)};
    pg8::gemm_phase<EpiDown, MoeSched, false, true>((LAS unsigned char*)F.lds, F.ws, DE, DE, DE / 128, S, E);
}

__device__ __forceinline__ void mkframe(Frame& F, const Args& args, unsigned char* l) {
    F.lds = l; F.ws = args.ws; F.ctl = (unsigned*)(args.ws + WS_CTL);
    F.tid = threadIdx.x; F.lane = F.tid & 63; F.wave = __builtin_amdgcn_readfirstlane(F.tid >> 6); F.G = gridDim.x; F.bid = blockIdx.x;
    F.in = args.in; F.out = args.out;
}
constexpr int NPHASE = 11;
__global__ void __launch_bounds__(NTHR, 2) fwd(Args args) {
    extern __shared__ __attribute__((aligned(16))) unsigned char lds[];
    Frame F; mkframe(F, args, lds);
    volatile LAS unsigned* misc = (volatile LAS unsigned*)((LAS unsigned char*)lds + LDS_BYTES - 64);
    if (F.tid < 16) misc[F.tid] = 0u;
    __syncthreads();
    const int lo = args.ph_lo, hi = args.ph_hi;
    XcdBarrier bar; bar.bar = F.ctl + CW_BAR; bar.x = 0; bar.st = misc;
    if (hi - lo > 1) bar = xcd_barrier_post(F.ctl + CW_BAR, misc);
#define IN(k) (lo <= (k) && (k) < hi)
#define SEAM(k) do { if (IN(k) && IN((k) + 1)) xcd_barrier(bar); } while (0)
#define SEAMF(k) do { if (IN(k) && IN((k) + 1)) xcd_barrier_fill(bar, F); } while (0)
#define RUNP(k, body) do { if (IN(k)) { body; } } while (0)
    RUNP(0, { if (F.bid < SG * 4 || F.G < 256) p0_s5tables(F);
              p0_prologue(F); }); SEAM(0);
    RUNP(1, f_proj(F)); SEAMF(1);
    RUNP(2, { f_attn(F); f_s5e(F); }); SEAMF(2);
    if (F.G < T / 256) { RUNP(3, f_s5scan(F)); SEAM(3); }
    if (F.G < T / 256) { RUNP(4, f_s5y(F)); SEAMF(4); }
    RUNP(5, f_glu(F)); SEAMF(5);
    RUNP(6, f_wout(F)); SEAMF(6);
    if (IN(7)) { f_ln1_router(F); moe_drain(F); }
    if (IN(7) && IN(9)) xcd_barrier(bar);
    RUNP(9, f_gateup(F)); SEAM(9);
    RUNP(10, f_down(F)); SEAM(10);
    RUNP(11, p_final(F));
#undef RUNP
#undef IN
#undef SEAM
#undef SEAMF
}

extern "C" void kernel_launch(void* const* d_in, const int* in_sizes, int n_in, void* d_out, int out_size, void* d_ws, size_t ws_size, hipStream_t stream) {
    static int grid = 0;
    if (grid == 0) {
        if (n_in != 25 || out_size != T * D || ws_size < WS_END) { fprintf(stderr, "kernel_launch: unexpected shapes n_in %d out %d ws %zu\n", n_in, out_size, ws_size); grid = -1; return; }
        int dev = 0, cus = 0;
        if (hipGetDevice(&dev) != hipSuccess || hipDeviceGetAttribute(&cus, hipDeviceAttributeMultiprocessorCount, dev) != hipSuccess) { grid = -1; return; }
        if (hipFuncSetAttribute((const void*)fwd, hipFuncAttributeMaxDynamicSharedMemorySize, LDS_BYTES) != hipSuccess) { fprintf(stderr, "kernel_launch: hipFuncSetAttribute failed\n"); grid = -1; return; }
        int per_cu = 0;
        if (hipOccupancyMaxActiveBlocksPerMultiprocessor(&per_cu, (const void*)fwd, NTHR, LDS_BYTES) != hipSuccess || per_cu < 1) fprintf(stderr, "kernel_launch: occupancy query says %d\n", per_cu);
        (void)hipGetLastError();
        grid = cus;
    }
    if (grid < 0) return;
    (void)hipMemsetAsync((char*)d_ws + WS_CTL, 0, CTL_ZERO_BYTES, stream);
    Args a{};
    for (int i = 0; i < 25; ++i) a.in[i] = (const float*)d_in[i];
    a.out = (float*)d_out; a.ws = (unsigned char*)d_ws;
#define LAUNCH_FAST(lo_, hi_) do { a.ph_lo = lo_; a.ph_hi = hi_; a.li = lo_; a.pad = 0; hipLaunchKernelGGL(fwd, dim3(grid), dim3(NTHR), LDS_BYTES, stream, a); } while (0)
#ifdef MK_PER_PHASE
    for (int p = 0; p < 12; ++p) LAUNCH_FAST(p, p + 1);
#else
    LAUNCH_FAST(0, 12);
#endif
}
```
